# Optimizing an MI355X kernel written in HIP

```python
import math
import jax, jax.numpy as jnp
from jax import lax
import numpy as np

D_MODEL = 1024
BATCH = 2
SEQ = 16384
DEPTH = 2

PLE_DIM = 256
GLA_HEADS = 4
GLA_DK = 32
GLA_DV = 64
GLA_RANK = 16
GLA_TAU = 16.0
GLA_CHUNK = 16
SWA_HEADS = 8
SWA_KV_HEADS = 2
SWA_HD = 64
SWA_WINDOW = 128
SWA_BLOCK = 128
ROPE_THETA = 10000.0
LRU_WIDTH = 256
LRU_BLOCKS = 4
LRU_BLOCK_DIM = LRU_WIDTH // LRU_BLOCKS
LRU_CONV = 4
LRU_C = 8.0
PEER_HEADS = 8
PEER_NKEYS = 128
PEER_N = PEER_NKEYS * PEER_NKEYS
PEER_DQ = 256
PEER_TOPK = 16
PEER_TOKEN_BLOCK = 128

IN_SPLIT_SIZES = [
    GLA_HEADS * GLA_DK, GLA_HEADS * GLA_DK, GLA_HEADS * GLA_DV, GLA_HEADS * GLA_DV, GLA_RANK,
    SWA_HEADS * SWA_HD, SWA_KV_HEADS * SWA_HD, SWA_KV_HEADS * SWA_HD,
    LRU_WIDTH, LRU_WIDTH,
]
IN_COLS = sum(IN_SPLIT_SIZES)
IN_SPLIT_POINTS = [int(s) for s in np.cumsum(IN_SPLIT_SIZES)[:-1]]
MIX_WIDTH = GLA_HEADS * GLA_DV + SWA_HEADS * SWA_HD + LRU_WIDTH

DEEPNORM_ALPHA = (2.0 * DEPTH) ** 0.25
DEEPNORM_BETA = (8.0 * DEPTH) ** -0.25
LN_EPS = 1e-5
RMS_EPS = 1e-6

kernel_name = "hymba_gla_swa_rglru_peer_deepnorm"

F32 = jnp.float32


def layer_norm(x, g, b):
    xf = x.astype(F32)
    mu = jnp.mean(xf, axis=-1, keepdims=True)
    var = jnp.mean(jnp.square(xf - mu), axis=-1, keepdims=True)
    return ((xf - mu) * lax.rsqrt(var + LN_EPS) * g.astype(F32) + b.astype(F32)).astype(x.dtype)


def rope_tables(positions):
    inv = ROPE_THETA ** (-jnp.arange(0, SWA_HD, 2, dtype=F32) / SWA_HD)
    ang = positions.astype(F32)[..., None] * inv
    return jnp.cos(ang), jnp.sin(ang)


def apply_rope(t, cos, sin):
    t1, t2 = jnp.split(t.astype(F32), 2, axis=-1)
    c = cos[:, :, None, :]
    s = sin[:, :, None, :]
    return jnp.concatenate([t1 * c - t2 * s, t2 * c + t1 * s], axis=-1)


def gla_mixer(q, k, v, g_out, a_low, w_a2, b_a, norm_w):
    B, S, _ = q.shape
    N = S // GLA_CHUNK
    log_a = jax.nn.log_sigmoid((a_low @ w_a2 + b_a).astype(F32)) / GLA_TAU

    def heads(t, d):
        return t.reshape(B, N, GLA_CHUNK, GLA_HEADS, d).transpose(0, 3, 1, 2, 4).astype(F32)

    qh = heads(q, GLA_DK) * (GLA_DK ** -0.5)
    kh = heads(k, GLA_DK)
    vh = heads(v, GLA_DV)
    b = jnp.cumsum(heads(log_a, GLA_DK), axis=3)
    b_last = b[:, :, :, -1:, :]
    q_dec = qh * jnp.exp(b)
    k_dec = kh * jnp.exp(-b)
    causal = jnp.tril(jnp.ones((GLA_CHUNK, GLA_CHUNK), dtype=bool))
    att = jnp.where(causal, jnp.einsum('bhnid,bhnjd->bhnij', q_dec, k_dec), 0.0)
    o_intra = jnp.einsum('bhnij,bhnjv->bhniv', att, vh)
    k_state = kh * jnp.exp(b_last - b)
    d_state = jnp.einsum('bhncd,bhncv->nbhdv', k_state, vh)
    decay = jnp.exp(b_last[:, :, :, 0, :]).transpose(2, 0, 1, 3)

    def step(state, inp):
        dec, ds = inp
        return dec[..., None] * state + ds, state

    s0 = jnp.zeros((B, GLA_HEADS, GLA_DK, GLA_DV), F32)
    _, s_before = lax.scan(step, s0, (decay, d_state))
    o_inter = jnp.einsum('bhncd,nbhdv->bhncv', q_dec, s_before)
    o = o_intra + o_inter
    o = o * lax.rsqrt(jnp.mean(jnp.square(o), axis=-1, keepdims=True) + RMS_EPS) * norm_w.astype(F32)
    o = o.transpose(0, 2, 3, 1, 4).reshape(B, S, GLA_HEADS * GLA_DV)
    return (o * jax.nn.silu(g_out.astype(F32))).astype(q.dtype)


def swa_mixer(q, k, v, cos, sin, sinks):
    B, S, _ = q.shape
    N = S // SWA_BLOCK
    G = SWA_HEADS // SWA_KV_HEADS
    qh = apply_rope(q.reshape(B, S, SWA_HEADS, SWA_HD), cos, sin)
    kh = apply_rope(k.reshape(B, S, SWA_KV_HEADS, SWA_HD), cos, sin)
    vh = v.reshape(B, S, SWA_KV_HEADS, SWA_HD).astype(F32)
    qb = qh.reshape(B, N, SWA_BLOCK, SWA_KV_HEADS, G, SWA_HD)

    def band(t):
        tb = t.reshape(B, N, SWA_BLOCK, SWA_KV_HEADS, SWA_HD)
        prev = jnp.pad(tb[:, :-1], ((0, 0), (1, 0), (0, 0), (0, 0), (0, 0)))
        return jnp.concatenate([prev, tb], axis=2)

    kb, vb = band(kh), band(vh)
    scores = jnp.einsum('bnqhgd,bnkhd->bnhgqk', qb, kb) * (SWA_HD ** -0.5)
    qi = jnp.arange(SWA_BLOCK)[:, None]
    kj = jnp.arange(2 * SWA_BLOCK)[None, :]
    rel = qi + SWA_BLOCK - kj
    in_window = (rel >= 0) & (rel < SWA_WINDOW)
    first_block = (jnp.arange(N) == 0)[:, None, None]
    valid = in_window[None] & ~(first_block & (kj < SWA_BLOCK)[None])
    scores = jnp.where(valid[None, :, None, None], scores, -jnp.inf)
    sink = jnp.broadcast_to(sinks.astype(F32).reshape(1, 1, SWA_KV_HEADS, G, 1, 1), scores.shape[:-1] + (1,))
    probs = jax.nn.softmax(jnp.concatenate([scores, sink], axis=-1), axis=-1)[..., :-1]
    out = jnp.einsum('bnhgqk,bnkhd->bnqhgd', probs, vb)
    return out.reshape(B, S, SWA_HEADS * SWA_HD).astype(q.dtype)


def rglru_mixer(gate_in, rec_in, conv_w, conv_b, w_r, b_r, w_i, b_i, lam):
    B, S, _ = rec_in.shape
    xc = lax.conv_general_dilated(
        rec_in, conv_w[:, None, :], window_strides=(1,), padding=[(LRU_CONV - 1, 0)],
        dimension_numbers=('NWC', 'WIO', 'NWC'), feature_group_count=LRU_WIDTH) + conv_b
    xcf = xc.astype(F32)
    xb = xcf.reshape(B, S, LRU_BLOCKS, LRU_BLOCK_DIM)
    r = jax.nn.sigmoid(jnp.einsum('bshi,hij->bshj', xb, w_r.astype(F32)).reshape(B, S, LRU_WIDTH) + b_r.astype(F32))
    ig = jax.nn.sigmoid(jnp.einsum('bshi,hij->bshj', xb, w_i.astype(F32)).reshape(B, S, LRU_WIDTH) + b_i.astype(F32))
    log_a = LRU_C * r * jax.nn.log_sigmoid(lam.astype(F32))
    a = jnp.exp(log_a)
    u = jnp.sqrt(-jnp.expm1(2.0 * log_a)) * (ig * xcf)

    def combine(left, right):
        a1, b1 = left
        a2, b2 = right
        return a1 * a2, a2 * b1 + b2

    _, h = lax.associative_scan(combine, (a, u), axis=1)
    return (jax.nn.gelu(gate_in.astype(F32)) * h).astype(rec_in.dtype)


def peer_ffn(x, w_q, sub_keys, u_tab, v_tab):
    B, S, D = x.shape
    T = B * S
    xt = x.reshape(T, D)
    q = (xt @ w_q).reshape(T, PEER_HEADS, 2, PEER_DQ // 2).astype(F32)
    s = jnp.einsum('thcd,hckd->thck', q, sub_keys.astype(F32))
    s_top, i_top = lax.top_k(s, PEER_TOPK)
    cand = s_top[:, :, 0, :, None] + s_top[:, :, 1, None, :]
    cand_idx = i_top[:, :, 0, :, None] * PEER_NKEYS + i_top[:, :, 1, None, :]
    cand = cand.reshape(T, PEER_HEADS, PEER_TOPK * PEER_TOPK)
    cand_idx = cand_idx.reshape(T, PEER_HEADS, PEER_TOPK * PEER_TOPK)
    best, pos = lax.top_k(cand, PEER_TOPK)
    experts = jnp.take_along_axis(cand_idx, pos, axis=-1)
    gates = jax.nn.softmax(best, axis=-1)
    nb = T // PEER_TOKEN_BLOCK
    E = PEER_HEADS * PEER_TOPK

    def eval_block(args):
        xb, eb, gb = args
        hidden = jax.nn.gelu(jnp.einsum('td,ted->te', xb, u_tab[eb]))
        return jnp.einsum('te,ted->td', gb * hidden, v_tab[eb])

    y = lax.map(eval_block, (xt.reshape(nb, PEER_TOKEN_BLOCK, D),
                             experts.reshape(nb, PEER_TOKEN_BLOCK, E),
                             gates.reshape(nb, PEER_TOKEN_BLOCK, E).astype(x.dtype)))
    return y.reshape(B, S, D)


def setup_inputs(seed: int = 0) -> dict:
    key = jax.random.key(seed)
    ks = jax.random.split(key, 32)
    L = DEPTH

    def nrm(k, shape, scale):
        return jax.random.normal(k, shape, F32) * scale

    x = jax.random.normal(ks[0], (BATCH, SEQ, D_MODEL), F32)
    p = jax.random.normal(ks[1], (DEPTH, BATCH, SEQ, PLE_DIM), F32)
    offset = jax.random.randint(ks[2], (BATCH, 1), 0, 4096, dtype=jnp.int32)
    positions = (offset + jnp.arange(SEQ, dtype=jnp.int32)[None, :]).astype(jnp.int32)

    a8 = jax.random.uniform(ks[12], (L, LRU_WIDTH), F32, 0.9, 0.999)
    s = a8 ** (1.0 / LRU_C)
    lru_lambda = jnp.log(s) - jnp.log1p(-s)

    return {
        "x": x,
        "p": p,
        "positions": positions,
        "w_in": nrm(ks[3], (L, D_MODEL, IN_COLS), D_MODEL ** -0.5),
        "gla_w_a2": nrm(ks[4], (L, GLA_RANK, GLA_HEADS * GLA_DK), GLA_RANK ** -0.5),
        "gla_b_a": nrm(ks[5], (L, GLA_HEADS * GLA_DK), 0.5),
        "gla_norm_w": 1.0 + nrm(ks[6], (L, GLA_DV), 0.02),
        "swa_sinks": nrm(ks[7], (L, SWA_HEADS), 1.0),
        "lru_conv_w": nrm(ks[8], (L, LRU_CONV, LRU_WIDTH), LRU_CONV ** -0.5),
        "lru_conv_b": nrm(ks[9], (L, LRU_WIDTH), 0.02),
        "lru_w_r": nrm(ks[10], (L, LRU_BLOCKS, LRU_BLOCK_DIM, LRU_BLOCK_DIM), LRU_BLOCK_DIM ** -0.5),
        "lru_b_r": nrm(ks[11], (L, LRU_WIDTH), 0.02),
        "lru_w_i": nrm(ks[13], (L, LRU_BLOCKS, LRU_BLOCK_DIM, LRU_BLOCK_DIM), LRU_BLOCK_DIM ** -0.5),
        "lru_b_i": nrm(ks[14], (L, LRU_WIDTH), 0.02),
        "lru_lambda": lru_lambda,
        "w_out": nrm(ks[15], (L, MIX_WIDTH, D_MODEL), DEEPNORM_BETA * MIX_WIDTH ** -0.5),
        "ln1_g": 1.0 + nrm(ks[16], (L, D_MODEL), 0.02),
        "ln1_b": nrm(ks[17], (L, D_MODEL), 0.02),
        "peer_w_q": nrm(ks[18], (L, D_MODEL, PEER_HEADS * PEER_DQ), D_MODEL ** -0.5),
        "peer_sub_keys": nrm(ks[19], (L, PEER_HEADS, 2, PEER_NKEYS, PEER_DQ // 2), (PEER_DQ // 2) ** -0.5),
        "peer_u": nrm(ks[20], (L, PEER_N, D_MODEL), D_MODEL ** -0.5),
        "peer_v": nrm(ks[21], (L, PEER_N, D_MODEL), DEEPNORM_BETA),
        "ple_w_gate": nrm(ks[22], (L, D_MODEL, D_MODEL), D_MODEL ** -0.5),
        "ple_w_proj": nrm(ks[23], (L, PLE_DIM, D_MODEL), DEEPNORM_BETA * PLE_DIM ** -0.5),
        "ln2_g": 1.0 + nrm(ks[24], (L, D_MODEL), 0.02),
        "ln2_b": nrm(ks[25], (L, D_MODEL), 0.02),
    }


def reference(x, p, positions, w_in, gla_w_a2, gla_b_a, gla_norm_w, swa_sinks,
              lru_conv_w, lru_conv_b, lru_w_r, lru_b_r, lru_w_i, lru_b_i, lru_lambda,
              w_out, ln1_g, ln1_b, peer_w_q, peer_sub_keys, peer_u, peer_v,
              ple_w_gate, ple_w_proj, ln2_g, ln2_b):
    cos, sin = rope_tables(positions)
    for i in range(DEPTH):
        h = x @ w_in[i]
        (g_q, g_k, g_v, g_g, g_a, s_q, s_k, s_v, r_gate, r_rec) = jnp.split(h, IN_SPLIT_POINTS, axis=-1)
        o_gla = gla_mixer(g_q, g_k, g_v, g_g, g_a, gla_w_a2[i], gla_b_a[i], gla_norm_w[i])
        o_swa = swa_mixer(s_q, s_k, s_v, cos, sin, swa_sinks[i])
        o_lru = rglru_mixer(r_gate, r_rec, lru_conv_w[i], lru_conv_b[i], lru_w_r[i], lru_b_r[i],
                            lru_w_i[i], lru_b_i[i], lru_lambda[i])
        mix = jnp.concatenate([o_gla, o_swa, o_lru], axis=-1) @ w_out[i]
        x = layer_norm(DEEPNORM_ALPHA * x + mix, ln1_g[i], ln1_b[i])
        y = peer_ffn(x, peer_w_q[i], peer_sub_keys[i], peer_u[i], peer_v[i])
        ple = jax.nn.sigmoid(x @ ple_w_gate[i]) * (p[i] @ ple_w_proj[i])
        x = layer_norm(DEEPNORM_ALPHA * x + y + ple, ln2_g[i], ln2_b[i])
    return x
```

```cpp
#include <hip/hip_runtime.h>
#include <hip/hip_cooperative_groups.h>
#include <cstdio>
#include <cstdint>
namespace cg = cooperative_groups;

#ifndef FUSED
#define FUSED 0
#endif

constexpr int NTH = 512;
constexpr int BATCH = 2, SEQ = 16384, T = BATCH * SEQ, DM = 1024;
constexpr int INC = 2064;
constexpr int C_GQ = 0, C_GK = 128, C_GV = 256, C_GG = 512, C_GA = 768, C_SQ = 784, C_SK = 1296, C_SV = 1424, C_RG = 1552, C_RR = 1808;
constexpr size_t MiB = 1u << 20;
constexpr size_t WS_X1 = 0, WS_H = 0, WS_O = 258 * MiB, WS_Q = 128 * MiB, WS_G = 128 * MiB, WS_P = 256 * MiB,
                 WS_CS = 386 * MiB, WS_LA = 394 * MiB, WS_LU = 426 * MiB, WS_AGP = 458 * MiB, WS_AGH = 459 * MiB,
                 WS_EXP = 460 * MiB, WS_GAT = 476 * MiB, WS_END = 492 * MiB;
constexpr int LDS_BYTES = 147456;
constexpr float DN_ALPHA = 1.4142135623730951f;

struct Params {
    const float *x, *p; const int* pos;
    const float *w_in, *gla_w_a2, *gla_b_a, *gla_norm_w, *swa_sinks, *lru_conv_w, *lru_conv_b, *lru_w_r, *lru_b_r, *lru_w_i, *lru_b_i,
                *lru_lambda, *w_out, *ln1_g, *ln1_b, *peer_w_q, *peer_sub_keys, *peer_u, *peer_v, *ple_w_gate, *ple_w_proj, *ln2_g, *ln2_b;
    float* out; unsigned char* ws;
};

__device__ const double ROPE_INV_TURNS[32] = {
    0.15915494309189535, 0.11934937021124886, 0.08949940160889101, 0.06711508300522726, 0.050329212104487035, 0.03774158471741977,
    0.0283021958306234, 0.02122365276477766, 0.015915494309189534, 0.011934937021124886, 0.008949940160889102, 0.006711508300522725,
    0.005032921210448704, 0.003774158471741977, 0.00283021958306234, 0.0021223652764777662, 0.0015915494309189536, 0.0011934937021124885,
    0.0008949940160889102, 0.0006711508300522726, 0.0005032921210448703, 0.00037741584717419774, 0.00028302195830623395,
    0.0002122365276477766, 0.00015915494309189535, 0.00011934937021124886, 8.949940160889102e-05, 6.711508300522725e-05,
    5.0329212104487035e-05, 3.774158471741978e-05, 2.8302195830623396e-05, 2.122365276477766e-05};

__device__ __forceinline__ float sigmoid_f(float x) { return 1.f / (1.f + expf(-x)); }
__device__ __forceinline__ float log_sigmoid_f(float x) { return fminf(x, 0.f) - log1pf(expf(-fabsf(x))); }
__device__ __forceinline__ float gelu_tanh_f(float x) { const float u = 0.7978845608028654f * (x + 0.044715f * x * x * x); return 0.5f * x * (1.f + tanhf(u)); }
__device__ __forceinline__ float wave_sum(float v) {
#pragma unroll
    for (int o = 32; o >= 1; o >>= 1) v += __shfl_xor(v, o);
    return v;
}

__device__ __forceinline__ void phase_rope(const Params& P) {
    float2* cs = (float2*)(P.ws + WS_CS);
    for (int idx = blockIdx.x * NTH + threadIdx.x; idx < T * 32; idx += gridDim.x * NTH) {
        const int t = idx >> 5, i = idx & 31;
        const double q4 = (double)P.pos[t] * ROPE_INV_TURNS[i] * 4.0;
        const double qn = rint(q4);
        const float th = (float)(q4 - qn) * 1.5707963267948966f;
        const float t2 = th * th;
        const float s = th * (1.f + t2 * (-1.f / 6.f + t2 * (1.f / 120.f + t2 * (-1.f / 5040.f + t2 * (1.f / 362880.f)))));
        const float c = 1.f + t2 * (-0.5f + t2 * (1.f / 24.f + t2 * (-1.f / 720.f + t2 * (1.f / 40320.f + t2 * (-1.f / 3628800.f)))));
        const int qi = ((int)(long long)qn) & 3;
        const float cc = (qi == 0) ? c : (qi == 1) ? -s : (qi == 2) ? -c : s;
        const float ss = (qi == 0) ? s : (qi == 1) ? c : (qi == 2) ? -s : -c;
        cs[idx] = make_float2(cc, ss);
    }
}

__device__ __forceinline__ void gemm_f32(const float* __restrict__ A, int lda, const float* __restrict__ B, int ldb, float* __restrict__ C, int ldc,
                                         int M, int N, int K, float* smem) {
    float* As = smem;
    float* Bs = smem + 16 * 132;
    const int tid = threadIdx.x, tx = tid & 31, ty = tid >> 5;
    const int ntm = M / 128, ntn = (N + 127) / 128;
    const int arow = tid >> 2, ak = (tid & 3) * 4;
    const int bk = tid >> 5, bn = (tid & 31) * 4;
    for (int tile = blockIdx.x; tile < ntm * ntn; tile += gridDim.x) {
        const int tm = tile / ntn, tn = tile % ntn;
        float acc[8][4];
#pragma unroll
        for (int i = 0; i < 8; ++i)
#pragma unroll
            for (int j = 0; j < 4; ++j) acc[i][j] = 0.f;
        const float* Ap = A + (size_t)(tm * 128 + arow) * lda + ak;
        const int bcol = tn * 128 + bn;
        const bool bvalid = bcol < N;
        const float* Bp = B + (size_t)bk * ldb + bcol;
        for (int k0 = 0; k0 < K; k0 += 16) {
            const float4 av = *(const float4*)(Ap + k0);
            float4 bv = make_float4(0.f, 0.f, 0.f, 0.f);
            if (bvalid) bv = *(const float4*)(Bp + (size_t)k0 * ldb);
            __syncthreads();
            As[(ak + 0) * 132 + arow] = av.x; As[(ak + 1) * 132 + arow] = av.y; As[(ak + 2) * 132 + arow] = av.z; As[(ak + 3) * 132 + arow] = av.w;
            *(float4*)(Bs + bk * 132 + bn) = bv;
            __syncthreads();
#pragma unroll
            for (int kk = 0; kk < 16; ++kk) {
                const float4 a0 = *(const float4*)(As + kk * 132 + ty * 4);
                const float4 a1 = *(const float4*)(As + kk * 132 + 64 + ty * 4);
                const float4 b = *(const float4*)(Bs + kk * 132 + tx * 4);
                const float a[8] = {a0.x, a0.y, a0.z, a0.w, a1.x, a1.y, a1.z, a1.w};
#pragma unroll
                for (int i = 0; i < 8; ++i) { acc[i][0] += a[i] * b.x; acc[i][1] += a[i] * b.y; acc[i][2] += a[i] * b.z; acc[i][3] += a[i] * b.w; }
            }
        }
        const int ccol = tn * 128 + tx * 4;
        if (ccol < N) {
#pragma unroll
            for (int i = 0; i < 8; ++i) {
                const int r = tm * 128 + (i < 4 ? ty * 4 + i : 64 + ty * 4 + (i - 4));
                *(float4*)(C + (size_t)r * ldc + ccol) = make_float4(acc[i][0], acc[i][1], acc[i][2], acc[i][3]);
            }
        }
    }
    __syncthreads();
}

__device__ __forceinline__ void gla_stage(const float* __restrict__ H, const float* __restrict__ w_a2, const float* __restrict__ b_a, int hd, size_t tok0,
                                          float* buf, int st_tid, int nst) {
    for (int i = st_tid; i < 64 * 32; i += nst) {
        const int tt = i >> 5, d = i & 31;
        const float* hrow = H + (tok0 + tt) * INC;
        buf[tt * 32 + d] = hrow[C_GQ + hd * 32 + d] * 0.17677669529663687f;
        buf[2048 + tt * 32 + d] = hrow[C_GK + hd * 32 + d];
        float z = b_a[hd * 32 + d];
#pragma unroll
        for (int r = 0; r < 16; ++r) z += hrow[C_GA + r] * w_a2[r * 128 + hd * 32 + d];
        buf[4096 + tt * 32 + d] = expf(log_sigmoid_f(z) * 0.0625f);
    }
    for (int i = st_tid; i < 64 * 64; i += nst) {
        const int tt = i >> 6, v = i & 63;
        const float* hrow = H + (tok0 + tt) * INC;
        buf[6144 + tt * 64 + v] = hrow[C_GV + hd * 64 + v];
        buf[10240 + tt * 64 + v] = hrow[C_GG + hd * 64 + v];
    }
}
__device__ __forceinline__ void gla_block(const Params& P, int layer, float* smem, int bh) {
    const int b = bh >> 2, hd = bh & 3;
    const float* H = (const float*)(P.ws + WS_H);
    float* O = (float*)(P.ws + WS_O);
    const float* w_a2 = P.gla_w_a2 + layer * 16 * 128;
    const float* b_a = P.gla_b_a + layer * 128;
    const int tid = threadIdx.x, wave = tid >> 6, lane = tid & 63;
    constexpr int CH = 64, BUF = CH * 224;
    float S[32];
#pragma unroll
    for (int d = 0; d < 32; ++d) S[d] = 0.f;
    const float nwl = P.gla_norm_w[layer * 64 + lane];
    const size_t base = (size_t)b * SEQ;
    gla_stage(H, w_a2, b_a, hd, base, smem, tid, NTH);
    __syncthreads();
    for (int c = 0; c < SEQ / CH; ++c) {
        float* cur = smem + (c & 1) * BUF;
        float* nxt = smem + ((c + 1) & 1) * BUF;
        if (wave == 0) {
            for (int tt = 0; tt < CH; ++tt) {
                const float* qs = cur + tt * 32;
                const float* ks = cur + 2048 + tt * 32;
                const float* as = cur + 4096 + tt * 32;
                const float vv = cur[6144 + tt * 64 + lane];
                const float gg = cur[10240 + tt * 64 + lane];
                float o = 0.f;
#pragma unroll
                for (int d4 = 0; d4 < 8; ++d4) {
                    const float4 a4 = *(const float4*)(as + d4 * 4), k4 = *(const float4*)(ks + d4 * 4), q4 = *(const float4*)(qs + d4 * 4);
                    S[d4 * 4 + 0] = a4.x * S[d4 * 4 + 0] + k4.x * vv; o += q4.x * S[d4 * 4 + 0];
                    S[d4 * 4 + 1] = a4.y * S[d4 * 4 + 1] + k4.y * vv; o += q4.y * S[d4 * 4 + 1];
                    S[d4 * 4 + 2] = a4.z * S[d4 * 4 + 2] + k4.z * vv; o += q4.z * S[d4 * 4 + 2];
                    S[d4 * 4 + 3] = a4.w * S[d4 * 4 + 3] + k4.w * vv; o += q4.w * S[d4 * 4 + 3];
                }
                const float ms = wave_sum(o * o) * (1.f / 64.f);
                const float r = rsqrtf(ms + 1e-6f);
                const float outv = o * r * nwl * (gg / (1.f + expf(-gg)));
                O[(base + (size_t)c * CH + tt) * DM + hd * 64 + lane] = outv;
            }
        } else if (c + 1 < SEQ / CH) {
            gla_stage(H, w_a2, b_a, hd, base + (size_t)(c + 1) * CH, nxt, tid - 64, NTH - 64);
        }
        __syncthreads();
    }
}

__device__ __forceinline__ void swa_item(const Params& P, int layer, float* smem, int item) {
    const int b = item >> 8, n = (item >> 1) & 127, kvh = item & 1;
    const float* H = (const float*)(P.ws + WS_H);
    float* O = (float*)(P.ws + WS_O);
    const float2* cs = (const float2*)(P.ws + WS_CS);
    float* Ks = smem;
    float* Vs = smem + 256 * 64;
    const int tid = threadIdx.x;
    const size_t blk0 = (size_t)b * SEQ + (size_t)n * 128;
    const int jstart = (n == 0) ? 128 : 0;
    for (int i = tid; i < 256 * 32; i += NTH) {
        const int j = i >> 5, d = i & 31;
        if (j >= jstart) {
            const size_t tk = blk0 - 128 + j;
            const float* hrow = H + tk * INC + C_SK + kvh * 64;
            const float k1 = hrow[d], k2 = hrow[32 + d];
            const float2 c = cs[tk * 32 + d];
            Ks[j * 64 + d] = k1 * c.x - k2 * c.y;
            Ks[j * 64 + 32 + d] = k2 * c.x + k1 * c.y;
        }
    }
    for (int i = tid; i < 256 * 16; i += NTH) {
        const int j = i >> 4, d4 = i & 15;
        if (j >= jstart) {
            const size_t tk = blk0 - 128 + j;
            *(float4*)(Vs + j * 64 + d4 * 4) = *(const float4*)(H + tk * INC + C_SV + kvh * 64 + d4 * 4);
        }
    }
    const int g = tid >> 7, qi = tid & 127, head = kvh * 4 + g;
    const size_t tq = blk0 + qi;
    float q[64];
    {
        const float* qrow = H + tq * INC + C_SQ + head * 64;
#pragma unroll
        for (int d4 = 0; d4 < 16; ++d4) {
            const float4 v = *(const float4*)(qrow + d4 * 4);
            q[d4 * 4 + 0] = v.x; q[d4 * 4 + 1] = v.y; q[d4 * 4 + 2] = v.z; q[d4 * 4 + 3] = v.w;
        }
#pragma unroll
        for (int d = 0; d < 32; ++d) {
            const float2 c = cs[tq * 32 + d];
            const float q1 = q[d], q2 = q[32 + d];
            q[d] = (q1 * c.x - q2 * c.y) * 0.125f;
            q[32 + d] = (q2 * c.x + q1 * c.y) * 0.125f;
        }
    }
    __syncthreads();
    float m = P.swa_sinks[layer * 8 + head], l = 1.f;
    float o[64];
#pragma unroll
    for (int d = 0; d < 64; ++d) o[d] = 0.f;
    const int wq0 = tid & 64;
    const int jlo = (wq0 + 1 > jstart) ? wq0 + 1 : jstart, jhi = wq0 + 192;
    for (int j = jlo; j < jhi; ++j) {
        const float* kr = Ks + j * 64;
        float s = 0.f;
#pragma unroll
        for (int d4 = 0; d4 < 16; ++d4) {
            const float4 k4 = *(const float4*)(kr + d4 * 4);
            s += q[d4 * 4 + 0] * k4.x + q[d4 * 4 + 1] * k4.y + q[d4 * 4 + 2] * k4.z + q[d4 * 4 + 3] * k4.w;
        }
        const bool valid = (j >= qi + 1) && (j <= qi + 128);
        s = valid ? s : -INFINITY;
        const float mn = fmaxf(m, s);
        const float sc = expf(m - mn), pj = expf(s - mn);
        l = l * sc + pj; m = mn;
        const float* vr = Vs + j * 64;
#pragma unroll
        for (int d4 = 0; d4 < 16; ++d4) {
            const float4 v4 = *(const float4*)(vr + d4 * 4);
            o[d4 * 4 + 0] = o[d4 * 4 + 0] * sc + pj * v4.x; o[d4 * 4 + 1] = o[d4 * 4 + 1] * sc + pj * v4.y;
            o[d4 * 4 + 2] = o[d4 * 4 + 2] * sc + pj * v4.z; o[d4 * 4 + 3] = o[d4 * 4 + 3] * sc + pj * v4.w;
        }
    }
    const float inv = 1.f / l;
    float* orow = O + tq * DM + 256 + head * 64;
#pragma unroll
    for (int d4 = 0; d4 < 16; ++d4) *(float4*)(orow + d4 * 4) = make_float4(o[d4 * 4] * inv, o[d4 * 4 + 1] * inv, o[d4 * 4 + 2] * inv, o[d4 * 4 + 3] * inv);
    __syncthreads();
}

__device__ __forceinline__ void lru1_item(const Params& P, int layer, float* smem, int item) {
    const int b = item >> 7, ch = item & 127;
    const float* H = (const float*)(P.ws + WS_H);
    float* LA = (float*)(P.ws + WS_LA);
    float* LU = (float*)(P.ws + WS_LU);
    float* AGP = (float*)(P.ws + WS_AGP);
    float* AGH = (float*)(P.ws + WS_AGH);
    float* Xs = smem;
    const int tid = threadIdx.x, c = tid & 255, half = tid >> 8;
    const size_t t0 = (size_t)b * SEQ + (size_t)ch * 128;
    const int tl0 = half * 64;
    {
        const float* cw = P.lru_conv_w + layer * 4 * 256;
        const float w0 = cw[c], w1 = cw[256 + c], w2 = cw[512 + c], w3 = cw[768 + c], bb = P.lru_conv_b[layer * 256 + c];
        const int tloc = ch * 128 + tl0;
        const float* hp = H + (t0 + tl0) * INC + C_RR + c;
        float r0 = (tloc >= 3) ? hp[-3 * INC] : 0.f, r1 = (tloc >= 2) ? hp[-2 * INC] : 0.f, r2 = (tloc >= 1) ? hp[-1 * INC] : 0.f;
        for (int tt = 0; tt < 64; ++tt) {
            const float r3 = hp[(size_t)tt * INC];
            Xs[(tl0 + tt) * 256 + c] = bb + w0 * r0 + w1 * r1 + w2 * r2 + w3 * r3;
            r0 = r1; r1 = r2; r2 = r3;
        }
    }
    __syncthreads();
    const int blk = c >> 6, j = c & 63;
    const float* wr = P.lru_w_r + layer * 16384 + blk * 4096 + j;
    const float* wi = P.lru_w_i + layer * 16384 + blk * 4096 + j;
    const float br = P.lru_b_r[layer * 256 + c], bi = P.lru_b_i[layer * 256 + c];
    const float lsl = 8.f * log_sigmoid_f(P.lru_lambda[layer * 256 + c]);
    float Pp = 1.f, Hl = 0.f;
    for (int tg = 0; tg < 8; ++tg) {
        const float* xr = Xs + (tl0 + tg * 8) * 256 + blk * 64;
        float ar[8], ai[8];
#pragma unroll
        for (int k = 0; k < 8; ++k) { ar[k] = br; ai[k] = bi; }
#pragma unroll 4
        for (int i = 0; i < 64; ++i) {
            const float wrv = wr[i * 64], wiv = wi[i * 64];
#pragma unroll
            for (int k = 0; k < 8; ++k) { const float xv = xr[k * 256 + i]; ar[k] += xv * wrv; ai[k] += xv * wiv; }
        }
#pragma unroll
        for (int k = 0; k < 8; ++k) {
            const int tt = tg * 8 + k;
            const float r = sigmoid_f(ar[k]), ig = sigmoid_f(ai[k]);
            const float la = lsl * r;
            const float a = expf(la);
            const float u = sqrtf(-expm1f(2.f * la)) * (ig * Xs[(tl0 + tt) * 256 + c]);
            const size_t t = t0 + tl0 + tt;
            LA[t * 256 + c] = a; LU[t * 256 + c] = u;
            Pp *= a; Hl = a * Hl + u;
        }
    }
    AGP[((size_t)b * 256 + ch * 2 + half) * 256 + c] = Pp;
    AGH[((size_t)b * 256 + ch * 2 + half) * 256 + c] = Hl;
    __syncthreads();
}

__device__ __forceinline__ void lru2_item(const Params& P, int layer, int item) {
    const int b = item >> 7, ch = item & 127;
    const float* H = (const float*)(P.ws + WS_H);
    const float* LA = (const float*)(P.ws + WS_LA);
    const float* LU = (const float*)(P.ws + WS_LU);
    const float* AGP = (const float*)(P.ws + WS_AGP);
    const float* AGH = (const float*)(P.ws + WS_AGH);
    float* O = (float*)(P.ws + WS_O);
    const int tid = threadIdx.x, c = tid & 255, half = tid >> 8;
    const int sub = ch * 2 + half;
    float h = 0.f;
#pragma unroll 8
    for (int s = 0; s < sub; ++s) h = AGP[((size_t)b * 256 + s) * 256 + c] * h + AGH[((size_t)b * 256 + s) * 256 + c];
    const size_t t0 = (size_t)b * SEQ + (size_t)ch * 128 + half * 64;
#pragma unroll 4
    for (int tt = 0; tt < 64; ++tt) {
        const size_t t = t0 + tt;
        h = LA[t * 256 + c] * h + LU[t * 256 + c];
        O[t * DM + 768 + c] = gelu_tanh_f(H[t * INC + C_RG + c]) * h;
    }
}

__device__ __forceinline__ void phase_ln1(const Params& P, int layer) {
    const float* xin = (layer == 0) ? P.x : P.out;
    float* X1 = (float*)(P.ws + WS_X1);
    const float* g = P.ln1_g + layer * DM; const float* bt = P.ln1_b + layer * DM;
    const int wave = threadIdx.x >> 6, lane = threadIdx.x & 63;
    for (int row = blockIdx.x * 8 + wave; row < T; row += gridDim.x * 8) {
        float4 v[4]; float s = 0.f;
#pragma unroll
        for (int j = 0; j < 4; ++j) {
            const size_t idx = (size_t)row * DM + j * 256 + lane * 4;
            const float4 a = *(const float4*)(xin + idx), m = *(const float4*)(X1 + idx);
            v[j] = make_float4(DN_ALPHA * a.x + m.x, DN_ALPHA * a.y + m.y, DN_ALPHA * a.z + m.z, DN_ALPHA * a.w + m.w);
            s += (v[j].x + v[j].y) + (v[j].z + v[j].w);
        }
        const float mean = wave_sum(s) * (1.f / DM);
        float s2 = 0.f;
#pragma unroll
        for (int j = 0; j < 4; ++j) {
            v[j].x -= mean; v[j].y -= mean; v[j].z -= mean; v[j].w -= mean;
            s2 += (v[j].x * v[j].x + v[j].y * v[j].y) + (v[j].z * v[j].z + v[j].w * v[j].w);
        }
        const float rstd = rsqrtf(wave_sum(s2) * (1.f / DM) + 1e-5f);
#pragma unroll
        for (int j = 0; j < 4; ++j) {
            const int col = j * 256 + lane * 4;
            const float4 gg = *(const float4*)(g + col), bb = *(const float4*)(bt + col);
            *(float4*)(X1 + (size_t)row * DM + col) = make_float4(v[j].x * rstd * gg.x + bb.x, v[j].y * rstd * gg.y + bb.y, v[j].z * rstd * gg.z + bb.z, v[j].w * rstd * gg.w + bb.w);
        }
    }
}
__device__ __forceinline__ void phase_ln2(const Params& P, int layer) {
    const float* X1 = (const float*)(P.ws + WS_X1);
    const float* G = (const float*)(P.ws + WS_G);
    const float* Pj = (const float*)(P.ws + WS_P);
    float* Y = P.out;
    const float* g = P.ln2_g + layer * DM; const float* bt = P.ln2_b + layer * DM;
    const int wave = threadIdx.x >> 6, lane = threadIdx.x & 63;
    for (int row = blockIdx.x * 8 + wave; row < T; row += gridDim.x * 8) {
        float4 v[4]; float s = 0.f;
#pragma unroll
        for (int j = 0; j < 4; ++j) {
            const size_t idx = (size_t)row * DM + j * 256 + lane * 4;
            const float4 a = *(const float4*)(X1 + idx), y = *(const float4*)(Y + idx), gt = *(const float4*)(G + idx), pj = *(const float4*)(Pj + idx);
            v[j] = make_float4(DN_ALPHA * a.x + y.x + sigmoid_f(gt.x) * pj.x, DN_ALPHA * a.y + y.y + sigmoid_f(gt.y) * pj.y,
                               DN_ALPHA * a.z + y.z + sigmoid_f(gt.z) * pj.z, DN_ALPHA * a.w + y.w + sigmoid_f(gt.w) * pj.w);
            s += (v[j].x + v[j].y) + (v[j].z + v[j].w);
        }
        const float mean = wave_sum(s) * (1.f / DM);
        float s2 = 0.f;
#pragma unroll
        for (int j = 0; j < 4; ++j) {
            v[j].x -= mean; v[j].y -= mean; v[j].z -= mean; v[j].w -= mean;
            s2 += (v[j].x * v[j].x + v[j].y * v[j].y) + (v[j].z * v[j].z + v[j].w * v[j].w);
        }
        const float rstd = rsqrtf(wave_sum(s2) * (1.f / DM) + 1e-5f);
#pragma unroll
        for (int j = 0; j < 4; ++j) {
            const int col = j * 256 + lane * 4;
            const float4 gg = *(const float4*)(g + col), bb = *(const float4*)(bt + col);
            *(float4*)(Y + (size_t)row * DM + col) = make_float4(v[j].x * rstd * gg.x + bb.x, v[j].y * rstd * gg.y + bb.y, v[j].z * rstd * gg.z + bb.z, v[j].w * rstd * gg.w + bb.w);
        }
    }
}

#define TOPK_INSERT(tv, ti, sv, si) do { float cv_ = (sv); int ci_ = (si); \
    _Pragma("unroll") for (int j_ = 0; j_ < 16; ++j_) { const bool gt_ = cv_ > tv[j_]; const float tf_ = tv[j_]; const int tn_ = ti[j_]; \
        tv[j_] = gt_ ? cv_ : tf_; ti[j_] = gt_ ? ci_ : tn_; cv_ = gt_ ? tf_ : cv_; ci_ = gt_ ? tn_ : ci_; } } while (0)

__device__ __forceinline__ void topk_item(const Params& P, int layer, float* smem, int item) {
    const int h = item & 7, tile = item >> 3;
    const float* Q = (const float*)(P.ws + WS_Q);
    int* EXP = (int*)(P.ws + WS_EXP);
    float* GAT = (float*)(P.ws + WS_GAT);
    const int tid = threadIdx.x;
    {
        const float4* src = (const float4*)(P.peer_sub_keys + ((size_t)layer * 8 + h) * 32768);
        float4* dst = (float4*)smem;
        for (int i = tid; i < 8192; i += NTH) dst[i] = src[i];
    }
    __syncthreads();
    const size_t t = (size_t)tile * 512 + tid;
    float s0[16], s1[16]; int i0[16], i1[16];
#pragma unroll
    for (int c = 0; c < 2; ++c) {
        float q[128];
        const float* qrow = Q + t * 2048 + h * 256 + c * 128;
#pragma unroll
        for (int d4 = 0; d4 < 32; ++d4) {
            const float4 v = *(const float4*)(qrow + d4 * 4);
            q[d4 * 4] = v.x; q[d4 * 4 + 1] = v.y; q[d4 * 4 + 2] = v.z; q[d4 * 4 + 3] = v.w;
        }
        float tv[16]; int ti[16];
#pragma unroll
        for (int j = 0; j < 16; ++j) { tv[j] = -INFINITY; ti[j] = 0; }
        const float* kb = smem + c * 16384;
        for (int k = 0; k < 128; ++k) {
            const float* kr = kb + k * 128;
            float s = 0.f;
#pragma unroll
            for (int d4 = 0; d4 < 32; ++d4) {
                const float4 k4 = *(const float4*)(kr + d4 * 4);
                s += q[d4 * 4] * k4.x + q[d4 * 4 + 1] * k4.y + q[d4 * 4 + 2] * k4.z + q[d4 * 4 + 3] * k4.w;
            }
            if (s > tv[15]) TOPK_INSERT(tv, ti, s, k);
        }
#pragma unroll
        for (int j = 0; j < 16; ++j) { if (c == 0) { s0[j] = tv[j]; i0[j] = ti[j]; } else { s1[j] = tv[j]; i1[j] = ti[j]; } }
    }
    float bv[16]; int bi[16];
#pragma unroll
    for (int j = 0; j < 16; ++j) { bv[j] = -INFINITY; bi[j] = 0; }
#pragma unroll
    for (int a = 0; a < 16; ++a)
#pragma unroll
        for (int bb = 0; bb < 16; ++bb)
            if ((a + 1) * (bb + 1) <= 16) { const float sv = s0[a] + s1[bb]; const int si = i0[a] * 128 + i1[bb]; TOPK_INSERT(bv, bi, sv, si); }
    float e[16], sum = 0.f;
#pragma unroll
    for (int j = 0; j < 16; ++j) { e[j] = expf(bv[j] - bv[0]); sum += e[j]; }
    const float inv = 1.f / sum;
    int4* eo = (int4*)(EXP + t * 128 + h * 16);
    float4* go = (float4*)(GAT + t * 128 + h * 16);
#pragma unroll
    for (int j4 = 0; j4 < 4; ++j4) {
        eo[j4] = make_int4(bi[j4 * 4], bi[j4 * 4 + 1], bi[j4 * 4 + 2], bi[j4 * 4 + 3]);
        go[j4] = make_float4(e[j4 * 4] * inv, e[j4 * 4 + 1] * inv, e[j4 * 4 + 2] * inv, e[j4 * 4 + 3] * inv);
    }
    __syncthreads();
}

__device__ __forceinline__ void phase_peer_eval(const Params& P, int layer) {
    const float* X1 = (const float*)(P.ws + WS_X1);
    const int* EXP = (const int*)(P.ws + WS_EXP);
    const float* GAT = (const float*)(P.ws + WS_GAT);
    const float* U = P.peer_u + (size_t)layer * 16384 * DM;
    const float* V = P.peer_v + (size_t)layer * 16384 * DM;
    float* Y = P.out;
    const int wave = threadIdx.x >> 6, lane = threadIdx.x & 63;
    for (int tok = blockIdx.x * 8 + wave; tok < T; tok += gridDim.x * 8) {
        float4 xv[4], yv[4];
#pragma unroll
        for (int j = 0; j < 4; ++j) { xv[j] = *(const float4*)(X1 + (size_t)tok * DM + j * 256 + lane * 4); yv[j] = make_float4(0.f, 0.f, 0.f, 0.f); }
        const int e_lo = EXP[(size_t)tok * 128 + lane], e_hi = EXP[(size_t)tok * 128 + 64 + lane];
        const float g_lo = GAT[(size_t)tok * 128 + lane], g_hi = GAT[(size_t)tok * 128 + 64 + lane];
#pragma unroll 2
        for (int e = 0; e < 128; ++e) {
            const int ex = (e < 64) ? __shfl(e_lo, e) : __shfl(e_hi, e - 64);
            const float gt = (e < 64) ? __shfl(g_lo, e) : __shfl(g_hi, e - 64);
            const float* ur = U + (size_t)ex * DM + lane * 4;
            const float* vr = V + (size_t)ex * DM + lane * 4;
            float4 uv[4], vv[4];
#pragma unroll
            for (int j = 0; j < 4; ++j) { uv[j] = *(const float4*)(ur + j * 256); vv[j] = *(const float4*)(vr + j * 256); }
            float d = 0.f;
#pragma unroll
            for (int j = 0; j < 4; ++j) d += uv[j].x * xv[j].x + uv[j].y * xv[j].y + uv[j].z * xv[j].z + uv[j].w * xv[j].w;
            d = wave_sum(d);
            const float hv = gelu_tanh_f(d) * gt;
#pragma unroll
            for (int j = 0; j < 4; ++j) { yv[j].x += hv * vv[j].x; yv[j].y += hv * vv[j].y; yv[j].z += hv * vv[j].z; yv[j].w += hv * vv[j].w; }
        }
#pragma unroll
        for (int j = 0; j < 4; ++j) *(float4*)(Y + (size_t)tok * DM + j * 256 + lane * 4) = yv[j];
    }
}

template <int PH>
__device__ __forceinline__ void run_phase(const Params& P, int layer, float* smem) {
    if constexpr (PH == 0) phase_rope(P);
    if constexpr (PH == 1) gemm_f32((layer == 0) ? P.x : P.out, DM, P.w_in + (size_t)layer * DM * INC, INC, (float*)(P.ws + WS_H), INC, T, INC, DM, smem);
    if constexpr (PH == 2) {
        if (blockIdx.x < 8) gla_block(P, layer, smem, blockIdx.x);
        else for (int it = blockIdx.x - 8; it < 768; it += gridDim.x - 8) { if (it < 512) swa_item(P, layer, smem, it); else lru1_item(P, layer, smem, it - 512); }
    }
    if constexpr (PH == 3) for (int it = blockIdx.x; it < 256; it += gridDim.x) lru2_item(P, layer, it);
    if constexpr (PH == 4) gemm_f32((const float*)(P.ws + WS_O), DM, P.w_out + (size_t)layer * DM * DM, DM, (float*)(P.ws + WS_X1), DM, T, DM, DM, smem);
    if constexpr (PH == 5) phase_ln1(P, layer);
    if constexpr (PH == 6) gemm_f32((const float*)(P.ws + WS_X1), DM, P.peer_w_q + (size_t)layer * DM * 2048, 2048, (float*)(P.ws + WS_Q), 2048, T, 2048, DM, smem);
    if constexpr (PH == 7) for (int it = blockIdx.x; it < 512; it += gridDim.x) topk_item(P, layer, smem, it);
    if constexpr (PH == 8) {
        phase_peer_eval(P, layer);
        gemm_f32((const float*)(P.ws + WS_X1), DM, P.ple_w_gate + (size_t)layer * DM * DM, DM, (float*)(P.ws + WS_G), DM, T, DM, DM, smem);
        gemm_f32(P.p + (size_t)layer * T * 256, 256, P.ple_w_proj + (size_t)layer * 256 * DM, DM, (float*)(P.ws + WS_P), DM, T, DM, 256, smem);
    }
    if constexpr (PH == 9) phase_ln2(P, layer);
}

#if !FUSED
template <int PH>
__global__ void __launch_bounds__(NTH) phase_kernel(Params P, int layer) {
    extern __shared__ __attribute__((aligned(16))) float smem[];
    run_phase<PH>(P, layer, smem);
}

#else
__global__ void __launch_bounds__(NTH) mega_kernel(Params P) {
    extern __shared__ __attribute__((aligned(16))) float smem[];
    cg::grid_group grid = cg::this_grid();
    for (int step = 0; step < 19; ++step) {
        const int ph = (step == 0) ? 0 : 1 + (step - 1) % 9, layer = (step == 0) ? 0 : (step - 1) / 9;
        switch (ph) {
            case 0: run_phase<0>(P, layer, smem); break;
            case 1: run_phase<1>(P, layer, smem); break;
            case 2: run_phase<2>(P, layer, smem); break;
            case 3: run_phase<3>(P, layer, smem); break;
            case 4: run_phase<4>(P, layer, smem); break;
            case 5: run_phase<5>(P, layer, smem); break;
            case 6: run_phase<6>(P, layer, smem); break;
            case 7: run_phase<7>(P, layer, smem); break;
            case 8: run_phase<8>(P, layer, smem); break;
            default: run_phase<9>(P, layer, smem); break;
        }
        grid.sync();
    }
}
#endif

#if !FUSED
template <int PH>
static void launch_phase(const Params& P, int layer, int grid, hipStream_t stream) {
    static bool attr_set = false;
    if (!attr_set) { (void)hipFuncSetAttribute((const void*)phase_kernel<PH>, hipFuncAttributeMaxDynamicSharedMemorySize, LDS_BYTES); attr_set = true; }
    hipLaunchKernelGGL(phase_kernel<PH>, dim3(grid), dim3(NTH), LDS_BYTES, stream, P, layer);
}

#endif

extern "C" void kernel_launch(void* const* d_in, const int* in_sizes, int n_in, void* d_out, int out_size, void* d_ws, size_t ws_size, hipStream_t stream) {
    static int grid = 0;
    if (grid == 0) {
        if (n_in != 26 || out_size != T * DM || ws_size < WS_END) { fprintf(stderr, "kernel_launch: unexpected shapes (n_in %d out %d ws %zu)\n", n_in, out_size, ws_size); grid = -1; return; }
        int dev = 0, cus = 0, per_cu = 0;
        (void)hipGetDevice(&dev);
        (void)hipDeviceGetAttribute(&cus, hipDeviceAttributeMultiprocessorCount, dev);
#if FUSED
        (void)hipFuncSetAttribute((const void*)mega_kernel, hipFuncAttributeMaxDynamicSharedMemorySize, LDS_BYTES);
        (void)hipOccupancyMaxActiveBlocksPerMultiprocessor(&per_cu, (const void*)mega_kernel, NTH, LDS_BYTES);
#else
        per_cu = 1;
#endif
        if (per_cu < 1 || cus < 1) { fprintf(stderr, "kernel_launch: occupancy query gave %d blocks/CU on %d CUs\n", per_cu, cus); grid = -1; return; }
        grid = cus * per_cu;
    }
    if (grid < 0) return;
    Params P{};
    const float** fp = (const float**)&P;
    P.x = (const float*)d_in[0]; P.p = (const float*)d_in[1]; P.pos = (const int*)d_in[2];
    P.w_in = (const float*)d_in[3]; P.gla_w_a2 = (const float*)d_in[4]; P.gla_b_a = (const float*)d_in[5]; P.gla_norm_w = (const float*)d_in[6];
    P.swa_sinks = (const float*)d_in[7]; P.lru_conv_w = (const float*)d_in[8]; P.lru_conv_b = (const float*)d_in[9]; P.lru_w_r = (const float*)d_in[10];
    P.lru_b_r = (const float*)d_in[11]; P.lru_w_i = (const float*)d_in[12]; P.lru_b_i = (const float*)d_in[13]; P.lru_lambda = (const float*)d_in[14];
    P.w_out = (const float*)d_in[15]; P.ln1_g = (const float*)d_in[16]; P.ln1_b = (const float*)d_in[17]; P.peer_w_q = (const float*)d_in[18];
    P.peer_sub_keys = (const float*)d_in[19]; P.peer_u = (const float*)d_in[20]; P.peer_v = (const float*)d_in[21]; P.ple_w_gate = (const float*)d_in[22];
    P.ple_w_proj = (const float*)d_in[23]; P.ln2_g = (const float*)d_in[24]; P.ln2_b = (const float*)d_in[25];
    P.out = (float*)d_out; P.ws = (unsigned char*)d_ws;
    (void)fp;
#if FUSED
    void* args[] = {&P};
    hipError_t e = hipLaunchCooperativeKernel((const void*)mega_kernel, dim3(grid), dim3(NTH), args, LDS_BYTES, stream);
    if (e != hipSuccess) fprintf(stderr, "cooperative launch failed: %s (grid %d)\n", hipGetErrorString(e), grid);
#else
    launch_phase<0>(P, 0, grid, stream);
    for (int layer = 0; layer < 2; ++layer) {
        launch_phase<1>(P, layer, grid, stream); launch_phase<2>(P, layer, grid, stream); launch_phase<3>(P, layer, grid, stream);
        launch_phase<4>(P, layer, grid, stream); launch_phase<5>(P, layer, grid, stream); launch_phase<6>(P, layer, grid, stream);
        launch_phase<7>(P, layer, grid, stream); launch_phase<8>(P, layer, grid, stream); launch_phase<9>(P, layer, grid, stream);
    }
#endif
}
```

```cpp
#include <hip/hip_runtime.h>
#include <hip/hip_cooperative_groups.h>
#include <cstdio>
#include <cstdint>
namespace cg = cooperative_groups;

#ifndef FUSED
#define FUSED 1
#endif
#ifndef PEER_FP4
#define PEER_FP4 1
#endif
#ifndef REPEAT_SUB
#define REPEAT_SUB 0
#endif
#ifndef REPEAT_MASK
#define REPEAT_MASK 0
#endif

constexpr int NTH = 512;
constexpr int BATCH = 2, SEQ = 16384, T = BATCH * SEQ, DM = 1024;
constexpr int INC = 2064, HP = 2048;
constexpr int C_GQ = 0, C_GK = 128, C_GV = 256, C_GG = 512, C_SQ = 768, C_SK = 1280, C_SV = 1408, C_RG = 1536, C_RR = 1792;
constexpr size_t MiB = 1u << 20;
constexpr size_t WS_WIN = 0, WS_WOUT = 9 * MiB, WS_WQG = 13 * MiB, WS_WPJ = 25 * MiB, WS_SKB = 26 * MiB, WS_WLRU = 27 * MiB, WS_WA = 27 * MiB + 262144,
                 WS_CS = 28 * MiB,
                 WS_UB = 36 * MiB, WS_VB = 68 * MiB,
                 WS_R1 = 100 * MiB,
                 WS_R2 = 244 * MiB,
                 WS_X1B = 372 * MiB,
                 WS_PE = 436 * MiB,
                 WS_BAR = 500 * MiB,
                 WS_PI = 500 * MiB + 65536,
                 WS_END = 501 * MiB;
constexpr size_t WS_H = WS_R1, WS_X1R = WS_R1, WS_EXP = WS_R1, WS_GAT = WS_R1 + 16 * MiB;
constexpr size_t WS_O = WS_R2, WS_LA = WS_R2 + 64 * MiB, WS_LU = WS_R2 + 96 * MiB, WS_Q = WS_R2, WS_XB = WS_R2;
constexpr size_t WS_PB = WS_X1B, WS_AGP = WS_X1B + 16 * MiB, WS_AGH = WS_X1B + 17 * MiB, WS_GS = WS_X1B + 18 * MiB, WS_GD = WS_X1B + 20 * MiB,
                 WS_GQT = WS_X1B + 21 * MiB, WS_GKT = WS_X1B + 29 * MiB, WS_AL = WS_X1B + 37 * MiB,     WS_GVT = WS_PE, WS_GDS = WS_PE + 16 * MiB, WS_GDEC = WS_PE + 32 * MiB;
constexpr int LDS_BYTES = 155648;
constexpr float DN_ALPHA = 1.4142135623730951f;

typedef unsigned short bf16_t;
typedef unsigned u32x4_t __attribute__((ext_vector_type(4)));
typedef unsigned u32x2_t __attribute__((ext_vector_type(2)));
typedef short bf16x8_t __attribute__((ext_vector_type(8)));
typedef float f32x4_t __attribute__((ext_vector_type(4)));
constexpr float FP8_SU = 256.f, FP8_SV = 16.f;

struct Params {
    const float *x, *p; const int* pos;
    const float *w_in, *gla_w_a2, *gla_b_a, *gla_norm_w, *swa_sinks, *lru_conv_w, *lru_conv_b, *lru_w_r, *lru_b_r, *lru_w_i, *lru_b_i,
                *lru_lambda, *w_out, *ln1_g, *ln1_b, *peer_w_q, *peer_sub_keys, *peer_u, *peer_v, *ple_w_gate, *ple_w_proj, *ln2_g, *ln2_b;
    float* out; unsigned char* ws;
    int wv, pad_;
};

__device__ const double ROPE_INV_TURNS[32] = {
    0.15915494309189535, 0.11934937021124886, 0.08949940160889101, 0.06711508300522726, 0.050329212104487035, 0.03774158471741977,
    0.0283021958306234, 0.02122365276477766, 0.015915494309189534, 0.011934937021124886, 0.008949940160889102, 0.006711508300522725,
    0.005032921210448704, 0.003774158471741977, 0.00283021958306234, 0.0021223652764777662, 0.0015915494309189536, 0.0011934937021124885,
    0.0008949940160889102, 0.0006711508300522726, 0.0005032921210448703, 0.00037741584717419774, 0.00028302195830623395,
    0.0002122365276477766, 0.00015915494309189535, 0.00011934937021124886, 8.949940160889102e-05, 6.711508300522725e-05,
    5.0329212104487035e-05, 3.774158471741978e-05, 2.8302195830623396e-05, 2.122365276477766e-05};

__device__ __forceinline__ float fast_exp(float x) { return __builtin_amdgcn_exp2f(x * 1.4426950408889634f); }
__device__ __forceinline__ float sigmoid_f(float x) { return __builtin_amdgcn_rcpf(1.f + __builtin_amdgcn_exp2f(-1.4426950408889634f * x)); }
__device__ __forceinline__ float log_sigmoid_f(float x) { return fminf(x, 0.f) - log1pf(expf(-fabsf(x))); }
typedef __fp16 h2x_t __attribute__((ext_vector_type(2)));
__device__ __forceinline__ float gelu_tanh_f(float x) { const float u = 0.7978845608028654f * (x + 0.044715f * x * x * x); return x * sigmoid_f(2.f * u); }
__device__ __forceinline__ int otid(int wv) { int l; asm volatile("v_mbcnt_lo_u32_b32 %0, -1, 0\n\tv_mbcnt_hi_u32_b32 %0, -1, %0" : "=v"(l)); return (wv << 6) | l; }
__device__ __forceinline__ float wave_sum(float v) {
#pragma unroll
    for (int o = 32; o >= 1; o >>= 1) v += __shfl_xor(v, o);
    return v;
}
__device__ __forceinline__ float wave_prefix_sum(float x) {
#define DPP_ADD_(ctrl, rmask) x += __uint_as_float((unsigned)__builtin_amdgcn_update_dpp(0, (int)__float_as_uint(x), ctrl, rmask, 0xf, false))
    DPP_ADD_(0x111, 0xf); DPP_ADD_(0x112, 0xf); DPP_ADD_(0x114, 0xf); DPP_ADD_(0x118, 0xf);
    DPP_ADD_(0x142, 0xa); DPP_ADD_(0x143, 0xc);
#undef DPP_ADD_
    return x;
}
__device__ __forceinline__ const void* uniform_ptr(const void* p) {
    const unsigned long long v = (unsigned long long)p;
    const unsigned lo = __builtin_amdgcn_readfirstlane((unsigned)v), hi = __builtin_amdgcn_readfirstlane((unsigned)(v >> 32));
    return (const void*)(((unsigned long long)hi << 32) | lo);
}
__device__ __forceinline__ unsigned pack2bf(float lo, float hi) {
    typedef float f2_t __attribute__((ext_vector_type(2))); typedef __bf16 b2_t __attribute__((ext_vector_type(2)));
    const f2_t v = {lo, hi}; const b2_t b = __builtin_convertvector(v, b2_t); return __builtin_bit_cast(unsigned, b);
}
__device__ __forceinline__ bf16_t f2bf(float f) { return (bf16_t)(pack2bf(f, 0.f) & 0xffffu); }
__device__ __forceinline__ float bf2f(bf16_t v) { return __uint_as_float((unsigned)v << 16); }
__device__ __forceinline__ float bflo(unsigned w) { return __uint_as_float(w << 16); }
__device__ __forceinline__ float bfhi(unsigned w) { return __uint_as_float(w & 0xffff0000u); }

namespace pg8 {
#define PG8_LAS __attribute__((address_space(3)))
typedef unsigned short bf16_t;
typedef short bf16x8 __attribute__((ext_vector_type(8)));
typedef float f32x4 __attribute__((ext_vector_type(4)));
typedef unsigned u32x4 __attribute__((ext_vector_type(4)));
constexpr int BM = 256, BK = 64, HALF = 128, HTB = HALF * BK * 2  , STAGE_BYTES = 8 * HTB, NXCD = 8, WGM = 8;

__host__ __device__ __forceinline__ int lds_byte(int r, int c) { const int st = (r >> 4) * 2 + (c >> 5), rr = r & 15, cc = c & 31, ob = rr * 64 + cc * 2; return st * 1024 + (ob ^ (((ob >> 9) & 1) << 5)); }
__host__ __device__ __forceinline__ void stage_rc(int b, int& R, int& C) { const int st = b / 1024, sb = b % 1024, swz = sb ^ (((sb >> 9) & 1) << 5); R = (st >> 1) * 16 + swz / 64; C = (st & 1) * 32 + (swz % 64) / 2; }
__host__ __device__ __forceinline__ int perm32(int rho) { const int n = rho >> 4, i = rho & 15; return 8 * (i >> 2) + 4 * n + (i & 3); }

struct Unit { int pm, pn; };
struct Gemm { const bf16_t* A; const bf16_t* Bt; int M, N, K, wv; };

struct StaticOrder {
    int nM, nN, nwg, G, c;
    __host__ __device__ void init(int M, int N, int G_, int c_) { nM = M / BM; nN = N / BM; nwg = nM * nN; G = G_; c = c_; }
    __host__ __device__ bool next(int i, Unit& u) const {
        const long L = (long)i * G + c; if (L >= nwg) return false;
        int wgid = (int)L; { const int q = nwg / NXCD, r = nwg % NXCD, xcd = wgid % NXCD, off = wgid / NXCD; wgid = (xcd < r ? xcd * (q + 1) : r * (q + 1) + (xcd - r) * q) + off; }
        const int nig = WGM * nN, gid = wgid / nig, fm = gid * WGM, gsz = (nM - fm) < WGM ? (nM - fm) : WGM;
        u.pm = fm + ((wgid % nig) % gsz); u.pn = (wgid % nig) / gsz; return true;
    }
    __device__ __forceinline__ void a_ready(const Unit&) const {}
    __device__ __forceinline__ void done(const Unit&) const {}
};

__device__ __forceinline__ unsigned cvt_pk_bf16(float lo, float hi) { unsigned r; asm volatile("v_cvt_pk_bf16_f32 %0, %1, %2" : "=v"(r) : "v"(lo), "v"(hi)); return r; }

template <class Epi, class Sched, bool ALIGN_EPI = false, bool SP2 = false>
__device__ __forceinline__ void gemm_phase(PG8_LAS unsigned char* lds, const Gemm g, const Sched& S, const Epi& E) {
    const int tid = otid(g.wv), wid = __builtin_amdgcn_readfirstlane(tid >> 6), lane = tid & 63, wr = wid >> 2, wc = wid & 3, fr = lane & 15, fq = lane >> 4;
    const int K = g.K, nt = K / BK;
    unsigned voffA[2], voffB[2];
#pragma unroll
    for (int i = 0; i < 2; ++i) { int R, C; stage_rc(tid * 16 + i * 8192, R, C); const int Rb = Epi::PERM ? ((R & ~31) + perm32(R & 31)) : R;
        voffA[i] = (unsigned)(R * K + C) * 2u; voffB[i] = (unsigned)(Rb * K + C) * 2u; }
    const size_t kstep = (size_t)(BK * 2);
    const size_t hstep = (size_t)HALF * K * 2;
    const size_t tstep = 2 * hstep;
    const unsigned ldsw = (unsigned)wid * 1024u;
    const int aoff = lds_byte(wr * 64 + fr, fq * 8), boff = lds_byte(wc * 32 + fr, fq * 8);
#define PG8_SA(b, h) (((b) * 2 + (h)) * HTB)
#define PG8_SB(b, h) ((4 + (b) * 2 + (h)) * HTB)
#define PG8_STAGE(bufoff, gbase, voff) do { _Pragma("unroll") for (int _i = 0; _i < 2; ++_i) \
        __builtin_amdgcn_global_load_lds((const unsigned*)((const char*)(gbase) + (voff)[_i]), (PG8_LAS unsigned*)(lds + (bufoff) + ldsw + _i * 8192), 16, 0, 0); } while (0)
#define PG8_LDA(dst, b, h) do { _Pragma("unroll") for (int m = 0; m < 4; ++m) _Pragma("unroll") for (int k = 0; k < 2; ++k) dst[m][k] = *(const PG8_LAS bf16x8*)(lds + PG8_SA(b, h) + aoff + m * 2048 + k * 1024); } while (0)
#define PG8_LDB(dst, b, h) do { _Pragma("unroll") for (int n = 0; n < 2; ++n) _Pragma("unroll") for (int k = 0; k < 2; ++k) dst[n][k] = *(const PG8_LAS bf16x8*)(lds + PG8_SB(b, h) + boff + n * 2048 + k * 1024); } while (0)
#define PG8_MMA(ai, bj, At, Bt) do { __builtin_amdgcn_s_setprio(1); _Pragma("unroll") for (int m = 0; m < 4; ++m) _Pragma("unroll") for (int n = 0; n < 2; ++n) _Pragma("unroll") for (int k = 0; k < 2; ++k) \
        acc[ai][bj][m][n] = __builtin_amdgcn_mfma_f32_16x16x32_bf16(Bt[n][k], At[m][k], acc[ai][bj][m][n], 0, 0, 0); __builtin_amdgcn_s_setprio(0); } while (0)
#define PG8_WAIT_V(n) asm volatile("s_waitcnt vmcnt(" #n ")" ::: "memory")
#define PG8_WAIT_L(n) asm volatile("s_waitcnt lgkmcnt(" #n ")" ::: "memory")
#define PG8_BAR __builtin_amdgcn_s_barrier()
#define PG8_SCHED __builtin_amdgcn_sched_barrier(0)
    Unit cur, nxt; int ui = 0;
    if (!S.next(0, cur)) return;
    f32x4 acc[2][2][4][2];
#pragma unroll
    for (int a = 0; a < 2; ++a)
#pragma unroll
        for (int b = 0; b < 2; ++b)
#pragma unroll
            for (int m = 0; m < 4; ++m)
#pragma unroll
                for (int n = 0; n < 2; ++n) acc[a][b][m][n] = (f32x4){0.f, 0.f, 0.f, 0.f};
    bf16x8 At[4][2], B0[2][2], B1[2][2];
    const char* cA = (const char*)g.A + (size_t)cur.pm * tstep; const char* cB = (const char*)g.Bt + (size_t)cur.pn * tstep;
    S.a_ready(cur);
    if constexpr (SP2) {
        PG8_STAGE(PG8_SB(0, 0), cB, voffB); PG8_STAGE(PG8_SB(0, 1), cB + hstep, voffB); PG8_STAGE(PG8_SA(0, 0), cA, voffA); PG8_STAGE(PG8_SA(0, 1), cA + hstep, voffA);
        if (wr == 1) PG8_BAR;
        PG8_WAIT_V(2); PG8_BAR;
        PG8_STAGE(PG8_SB(1, 0), cB + kstep, voffB); PG8_STAGE(PG8_SA(1, 0), cA + kstep, voffA); PG8_STAGE(PG8_SB(1, 1), cB + hstep + kstep, voffB);
        PG8_WAIT_V(6); PG8_BAR;
    } else {
        PG8_STAGE(PG8_SB(0, 0), cB, voffB); PG8_STAGE(PG8_SA(0, 0), cA, voffA); PG8_STAGE(PG8_SB(0, 1), cB + hstep, voffB); PG8_STAGE(PG8_SA(0, 1), cA + hstep, voffA);
        if (wr == 1) PG8_BAR;
        PG8_WAIT_V(4); PG8_BAR;
        PG8_STAGE(PG8_SB(1, 0), cB + kstep, voffB); PG8_STAGE(PG8_SA(1, 0), cA + kstep, voffA); PG8_STAGE(PG8_SB(1, 1), cB + hstep + kstep, voffB);
        PG8_WAIT_V(6); PG8_BAR;
    }
    for (;;) {
        const bool has_next = S.next(ui + 1, nxt);
        const char* nA = has_next ? (const char*)g.A + (size_t)nxt.pm * tstep : cA; const char* nB = has_next ? (const char*)g.Bt + (size_t)nxt.pn * tstep : cB;
        for (int t = 0; t < nt; t += 2) {
            const bool last = (t == nt - 2);
            const char* a1 = cA + (size_t)(t + 1) * kstep;
            const char* a2 = last ? nA : cA + (size_t)(t + 2) * kstep; const char* b2 = last ? nB : cB + (size_t)(t + 2) * kstep;
            const char* a3 = a2 + kstep; const char* b3 = b2 + kstep;
            if (last && has_next) S.a_ready(nxt);
            if constexpr (SP2) {
            PG8_LDB(B0, 0, 0); PG8_LDB(B1, 0, 1); PG8_SCHED; PG8_LDA(At, 0, 0); PG8_STAGE(PG8_SA(1, 1), a1 + hstep, voffA);
            PG8_WAIT_V(8); PG8_WAIT_L(0); PG8_BAR; PG8_MMA(0, 0, At, B0); PG8_MMA(0, 1, At, B1); PG8_BAR; PG8_SCHED;
            PG8_LDA(At, 0, 1); PG8_STAGE(PG8_SB(0, 0), b2, voffB); PG8_STAGE(PG8_SB(0, 1), b2 + hstep, voffB); PG8_STAGE(PG8_SA(0, 0), a2, voffA);
            PG8_WAIT_V(8); PG8_WAIT_L(0); PG8_BAR; PG8_MMA(1, 0, At, B0); PG8_MMA(1, 1, At, B1); PG8_BAR; PG8_SCHED;
            PG8_LDB(B0, 1, 0); PG8_LDB(B1, 1, 1); PG8_SCHED; PG8_LDA(At, 1, 0); PG8_STAGE(PG8_SA(0, 1), a2 + hstep, voffA);
            PG8_WAIT_V(8); PG8_WAIT_L(0); PG8_BAR; PG8_MMA(0, 0, At, B0); PG8_MMA(0, 1, At, B1); PG8_BAR; PG8_SCHED;
            PG8_LDA(At, 1, 1); PG8_STAGE(PG8_SB(1, 0), b3, voffB); PG8_STAGE(PG8_SB(1, 1), b3 + hstep, voffB); PG8_STAGE(PG8_SA(1, 0), a3, voffA);
            PG8_WAIT_V(8); PG8_WAIT_L(0); PG8_BAR; PG8_MMA(1, 0, At, B0); PG8_MMA(1, 1, At, B1); PG8_BAR; PG8_SCHED;
            } else {
            PG8_LDB(B0, 0, 0); PG8_SCHED; PG8_LDA(At, 0, 0); PG8_STAGE(PG8_SA(1, 1), a1 + hstep, voffA);
            PG8_WAIT_L(8); PG8_BAR; PG8_WAIT_L(0); PG8_MMA(0, 0, At, B0); PG8_BAR; PG8_SCHED;
            PG8_LDB(B1, 0, 1); PG8_STAGE(PG8_SB(0, 0), b2, voffB);
            PG8_BAR; PG8_WAIT_L(0); PG8_MMA(0, 1, At, B1); PG8_BAR;
            PG8_LDA(At, 0, 1); PG8_STAGE(PG8_SA(0, 0), a2, voffA);
            PG8_BAR; PG8_WAIT_L(0); PG8_MMA(1, 0, At, B0); PG8_BAR; PG8_SCHED;
            PG8_STAGE(PG8_SB(0, 1), b2 + hstep, voffB);
            PG8_WAIT_V(6); PG8_BAR; PG8_MMA(1, 1, At, B1); PG8_BAR;
            PG8_LDB(B0, 1, 0); PG8_SCHED; PG8_LDA(At, 1, 0); PG8_STAGE(PG8_SA(0, 1), a2 + hstep, voffA);
            PG8_WAIT_L(8); PG8_BAR; PG8_WAIT_L(0); PG8_MMA(0, 0, At, B0); PG8_BAR; PG8_SCHED;
            PG8_LDB(B1, 1, 1); PG8_STAGE(PG8_SB(1, 0), b3, voffB);
            PG8_BAR; PG8_WAIT_L(0); PG8_MMA(0, 1, At, B1); PG8_BAR;
            PG8_LDA(At, 1, 1); PG8_STAGE(PG8_SA(1, 0), a3, voffA);
            PG8_BAR; PG8_WAIT_L(0); PG8_MMA(1, 0, At, B0); PG8_BAR; PG8_SCHED;
            PG8_STAGE(PG8_SB(1, 1), b3 + hstep, voffB);
            PG8_WAIT_V(6); PG8_BAR; PG8_MMA(1, 1, At, B1); PG8_BAR;
            }
        }
        if constexpr (ALIGN_EPI) { if (wr == 0) PG8_BAR; }
        if constexpr (!Epi::AFTER_DRAIN) { E(acc, cur, wr, wc, fr, fq); S.done(cur); }
        if (!has_next) break;
#pragma unroll
        for (int a = 0; a < 2; ++a)
#pragma unroll
            for (int b = 0; b < 2; ++b)
#pragma unroll
                for (int m = 0; m < 4; ++m)
#pragma unroll
                    for (int n = 0; n < 2; ++n) acc[a][b][m][n] = (f32x4){0.f, 0.f, 0.f, 0.f};
        cur = nxt; cA = nA; cB = nB; ++ui;
        if constexpr (ALIGN_EPI) { if (wr == 1) PG8_BAR; }
    }
    PG8_WAIT_V(0);
    if constexpr (!ALIGN_EPI) { if (wr == 0) PG8_BAR; }
    PG8_BAR;
    if constexpr (Epi::AFTER_DRAIN) { E.fused(acc, cur, wr, wc, fr, fq, lds, wid, lane); S.done(cur); }
#undef PG8_SA
#undef PG8_SB
#undef PG8_STAGE
#undef PG8_LDA
#undef PG8_LDB
#undef PG8_MMA
#undef PG8_WAIT_V
#undef PG8_WAIT_L
#undef PG8_BAR
#undef PG8_SCHED
}
}


namespace pg8 {
struct EpiBf16P {
    static constexpr bool PERM = true, AFTER_DRAIN = false;
    bf16_t* O; int ldc;
    __device__ __forceinline__ void operator()(const f32x4 (&acc)[2][2][4][2], const Unit& u, int wr, int wc, int fr, int fq) const {
        const int row0 = u.pm * BM + wr * 64 + fr, col0 = u.pn * BM + wc * 32 + 8 * fq;
#pragma unroll
        for (int ai = 0; ai < 2; ++ai)
#pragma unroll
            for (int m = 0; m < 4; ++m) { bf16_t* rowp = O + (size_t)(row0 + ai * HALF + m * 16) * ldc + col0;
#pragma unroll
                for (int bj = 0; bj < 2; ++bj) { const f32x4 v0 = acc[ai][bj][m][0], v1 = acc[ai][bj][m][1];
                    u32x4 w; w.x = pack2bf(v0[0], v0[1]); w.y = pack2bf(v0[2], v0[3]); w.z = pack2bf(v1[0], v1[1]); w.w = pack2bf(v1[2], v1[3]);
                    *(u32x4*)(rowp + bj * HALF) = w; } }
    }
};
struct EpiF32P {
    static constexpr bool PERM = false, AFTER_DRAIN = false;
    float* C; int ldc;
    __device__ __forceinline__ void operator()(const f32x4 (&acc)[2][2][4][2], const Unit& u, int wr, int wc, int fr, int fq) const {
        const int row0 = u.pm * BM + wr * 64 + fr, col0 = u.pn * BM + wc * 32 + 4 * fq;
#pragma unroll
        for (int ai = 0; ai < 2; ++ai)
#pragma unroll
            for (int m = 0; m < 4; ++m) { float* rowp = C + (size_t)(row0 + ai * HALF + m * 16) * ldc + col0;
#pragma unroll
                for (int bj = 0; bj < 2; ++bj)
#pragma unroll
                    for (int n = 0; n < 2; ++n) *(f32x4*)(rowp + bj * HALF + n * 16) = acc[ai][bj][m][n]; }
    }
};
__device__ __forceinline__ float fast_sigmoid(float x) { return __builtin_amdgcn_rcpf(1.f + __builtin_amdgcn_exp2f(-1.4426950408889634f * x)); }
struct EpiQG {
    static constexpr bool PERM = true, AFTER_DRAIN = false;
    bf16_t* Q; bf16_t* PE;
    __device__ __forceinline__ void operator()(const f32x4 (&acc)[2][2][4][2], const Unit& u, int wr, int wc, int fr, int fq) const {
        const int row0 = u.pm * BM + wr * 64 + fr;
        if (u.pn < 8) {
            const int col0 = u.pn * BM + wc * 32 + 8 * fq;
#pragma unroll
            for (int ai = 0; ai < 2; ++ai)
#pragma unroll
                for (int m = 0; m < 4; ++m) { bf16_t* rowp = Q + (size_t)(row0 + ai * HALF + m * 16) * 2048 + col0;
#pragma unroll
                    for (int bj = 0; bj < 2; ++bj) { const f32x4 v0 = acc[ai][bj][m][0], v1 = acc[ai][bj][m][1];
                        u32x4 w; w.x = pack2bf(v0[0], v0[1]); w.y = pack2bf(v0[2], v0[3]); w.z = pack2bf(v1[0], v1[1]); w.w = pack2bf(v1[2], v1[3]);
                        *(u32x4*)(rowp + bj * HALF) = w; } }
        } else {
            const int col0 = (u.pn - 8) * BM + wc * 32 + 8 * fq;
#pragma unroll
            for (int ai = 0; ai < 2; ++ai)
#pragma unroll
                for (int m = 0; m < 4; ++m) { bf16_t* rowp = PE + (size_t)(row0 + ai * HALF + m * 16) * 1024 + col0;
#pragma unroll
                    for (int bj = 0; bj < 2; ++bj) { const f32x4 v0 = acc[ai][bj][m][0], v1 = acc[ai][bj][m][1];
                        const u32x4 pp = *(const u32x4*)(rowp + bj * HALF);
                        u32x4 w;
                        w.x = pack2bf(fast_sigmoid(v0[0]) * bflo(pp.x), fast_sigmoid(v0[1]) * bfhi(pp.x));
                        w.y = pack2bf(fast_sigmoid(v0[2]) * bflo(pp.y), fast_sigmoid(v0[3]) * bfhi(pp.y));
                        w.z = pack2bf(fast_sigmoid(v1[0]) * bflo(pp.z), fast_sigmoid(v1[1]) * bfhi(pp.z));
                        w.w = pack2bf(fast_sigmoid(v1[2]) * bflo(pp.w), fast_sigmoid(v1[3]) * bfhi(pp.w));
                        *(u32x4*)(rowp + bj * HALF) = w; } }
        }
    }
};
}

template <class Epi>
__device__ __forceinline__ void run_gemm(float* smem, const bf16_t* A, const bf16_t* Bt, int M, int N, int K, const Epi& E, int wv) {
    pg8::Gemm g{A, Bt, M, N, K, wv};
    pg8::StaticOrder S; S.init(M, N, (int)gridDim.x, (int)blockIdx.x);
    pg8::gemm_phase<Epi, pg8::StaticOrder, true, true>((PG8_LAS unsigned char*)smem, g, S, E);
    __syncthreads();
}

__device__ __forceinline__ void rope_table(const Params& P, int gtid, int gnth) {
    float2* cs = (float2*)(P.ws + WS_CS);
    for (int idx = gtid; idx < T * 32; idx += gnth) {
        const int t = idx >> 5, i = idx & 31;
        const double q4 = (double)P.pos[t] * ROPE_INV_TURNS[i] * 4.0;
        const double qn = rint(q4);
        const float th = (float)(q4 - qn) * 1.5707963267948966f;
        const float t2 = th * th;
        const float s = th * (1.f + t2 * (-1.f / 6.f + t2 * (1.f / 120.f + t2 * (-1.f / 5040.f + t2 * (1.f / 362880.f)))));
        const float c = 1.f + t2 * (-0.5f + t2 * (1.f / 24.f + t2 * (-1.f / 720.f + t2 * (1.f / 40320.f + t2 * (-1.f / 3628800.f)))));
        const int qi = ((int)(long long)qn) & 3;
        const float cc = (qi == 0) ? c : (qi == 1) ? -s : (qi == 2) ? -c : s;
        const float ss = (qi == 0) ? s : (qi == 1) ? c : (qi == 2) ? -s : -c;
        cs[idx] = make_float2(cc, ss);
    }
}
__device__ __forceinline__ void transpose_item(const float* __restrict__ W, int K, int ldw, int col0, int nvalid, bf16_t* __restrict__ WT, int row_off, int nblk, int item, float* smem, int tid) {
    const int kb = item / nblk, nb = item % nblk, k0 = kb * 64, n0 = nb * 64;
    {
        const int nn = tid & 63, kk0 = tid >> 6;
#pragma unroll
        for (int i = 0; i < 8; ++i) { const int kk = kk0 + i * 8; const int n = n0 + nn; smem[kk * 65 + nn] = (n < nvalid) ? W[(size_t)(k0 + kk) * ldw + col0 + n] : 0.f; }
    }
    __syncthreads();
    {
        const int kk2 = (tid & 31) * 2, nn0 = tid >> 5;
#pragma unroll
        for (int i = 0; i < 4; ++i) { const int nn = nn0 + i * 16;
            *(unsigned*)(WT + (size_t)(row_off + n0 + nn) * K + k0 + kk2) = pack2bf(smem[kk2 * 65 + nn], smem[(kk2 + 1) * 65 + nn]); }
    }
    __syncthreads();
}
__device__ __forceinline__ void transpose_item4(const float* __restrict__ W, int K, int ldw, int col0, bf16_t* __restrict__ WT, int row_off, int nblk4, int item, float* smem, int tid) {
    const int kb = item / nblk4, nb = item % nblk4, k0 = kb * 64, n0 = nb * 256;
    {
        const int nn = tid & 255, kk0 = tid >> 8;
#pragma unroll
        for (int i = 0; i < 32; ++i) { const int kk = kk0 + i * 2; smem[kk * 257 + nn] = W[(size_t)(k0 + kk) * ldw + col0 + n0 + nn]; }
    }
    __syncthreads();
    {
        const int kk2 = (tid & 31) * 2, nn0 = tid >> 5;
#pragma unroll
        for (int i = 0; i < 16; ++i) { const int nn = nn0 + i * 16;
            *(unsigned*)(WT + (size_t)(row_off + n0 + nn) * K + k0 + kk2) = pack2bf(smem[kk2 * 257 + nn], smem[(kk2 + 1) * 257 + nn]); }
    }
    __syncthreads();
}
__device__ __forceinline__ void convert_bf16(const float* __restrict__ src, bf16_t* __restrict__ dst, size_t n, int gtid, int gnth) {
    const size_t step = (size_t)gnth * 8;
    size_t i = (size_t)gtid * 8;
    for (; i + 3 * step < n; i += 4 * step) {
        const f32x4_t a0 = *(const f32x4_t*)(src + i), b0 = *(const f32x4_t*)(src + i + 4);
        const f32x4_t a1 = *(const f32x4_t*)(src + i + step), b1 = *(const f32x4_t*)(src + i + step + 4);
        const f32x4_t a2 = *(const f32x4_t*)(src + i + 2 * step), b2 = *(const f32x4_t*)(src + i + 2 * step + 4);
        const f32x4_t a3 = *(const f32x4_t*)(src + i + 3 * step), b3 = *(const f32x4_t*)(src + i + 3 * step + 4);
        u32x4_t w;
        w.x = pack2bf(a0[0], a0[1]); w.y = pack2bf(a0[2], a0[3]); w.z = pack2bf(b0[0], b0[1]); w.w = pack2bf(b0[2], b0[3]); *(u32x4_t*)(dst + i) = w;
        w.x = pack2bf(a1[0], a1[1]); w.y = pack2bf(a1[2], a1[3]); w.z = pack2bf(b1[0], b1[1]); w.w = pack2bf(b1[2], b1[3]); *(u32x4_t*)(dst + i + step) = w;
        w.x = pack2bf(a2[0], a2[1]); w.y = pack2bf(a2[2], a2[3]); w.z = pack2bf(b2[0], b2[1]); w.w = pack2bf(b2[2], b2[3]); *(u32x4_t*)(dst + i + 2 * step) = w;
        w.x = pack2bf(a3[0], a3[1]); w.y = pack2bf(a3[2], a3[3]); w.z = pack2bf(b3[0], b3[1]); w.w = pack2bf(b3[2], b3[3]); *(u32x4_t*)(dst + i + 3 * step) = w;
    }
    for (; i < n; i += step) {
        const f32x4_t a = *(const f32x4_t*)(src + i), b = *(const f32x4_t*)(src + i + 4);
        u32x4_t w; w.x = pack2bf(a[0], a[1]); w.y = pack2bf(a[2], a[3]); w.z = pack2bf(b[0], b[1]); w.w = pack2bf(b[2], b[3]);
        *(u32x4_t*)(dst + i) = w;
    }
}
__device__ __forceinline__ void convert_fp8(const float* __restrict__ src, unsigned char* __restrict__ dst, size_t n, float scale, int gtid, int gnth) {
    for (size_t i = (size_t)gtid * 16; i < n; i += (size_t)gnth * 16) {
        u32x4_t w;
#pragma unroll
        for (int j = 0; j < 4; ++j) {
            const float4 a = *(const float4*)(src + i + j * 4);
            const float c0 = fminf(fmaxf(a.x * scale, -448.f), 448.f), c1 = fminf(fmaxf(a.y * scale, -448.f), 448.f);
            const float c2 = fminf(fmaxf(a.z * scale, -448.f), 448.f), c3 = fminf(fmaxf(a.w * scale, -448.f), 448.f);
            int v = 0;
            v = __builtin_amdgcn_cvt_pk_fp8_f32(c0, c1, v, false);
            v = __builtin_amdgcn_cvt_pk_fp8_f32(c2, c3, v, true);
            w[j] = (unsigned)v;
        }
        *(u32x4_t*)(dst + i) = w;
    }
}
typedef int v8i_t __attribute__((ext_vector_type(8)));
__device__ __forceinline__ unsigned mx_code(unsigned q) { return q < 126u ? q + 1u : (q == 126u ? 0x81u : 0x82u); }
__device__ __forceinline__ void calibrate_mx(const Params& P) {
    const int tid = otid(P.wv);
    if ((int)blockIdx.x * 8 >= 128) return;
    unsigned char* PI = (unsigned char*)(P.ws + WS_PI);
    const int lane = tid & 63, kb = lane >> 4;
    v8i_t bv;
#pragma unroll
    for (int t = 0; t < 8; ++t) { unsigned w = 0; for (int bb = 0; bb < 4; ++bb) w |= mx_code((unsigned)(kb * 32 + 4 * t + bb)) << (8 * bb); bv[t] = (int)w; }
    const unsigned c_lo = mx_code((unsigned)lane), c_hi = mx_code((unsigned)lane + 64u);
    const float cand_lo = __builtin_amdgcn_cvt_pk_f32_fp8((int)(c_lo | (c_lo << 8)), false)[0], cand_hi = __builtin_amdgcn_cvt_pk_f32_fp8((int)(c_hi | (c_hi << 8)), false)[0];
    for (int p = blockIdx.x * 8 + (tid >> 6); p < 128; p += gridDim.x * 8) {
        const int pe = (kb == (p >> 5)) ? (p & 31) : -1;
        v8i_t av = {0, 0, 0, 0, 0, 0, 0, 0};
#pragma unroll
        for (int dI = 0; dI < 4; ++dI) {
            unsigned v = 0;
#define OH_(sx) v = __builtin_amdgcn_cvt_scalef32_pk_fp4_f32(v, (pe == 8 * dI + 2 * sx) ? 1.0f : 0.0f, (pe == 8 * dI + 2 * sx + 1) ? 1.0f : 0.0f, 1.0f, sx)
            OH_(0); OH_(1); OH_(2); OH_(3);
#undef OH_
            av[dI] = (int)v;
        }
        f32x4_t d = (f32x4_t){0.f, 0.f, 0.f, 0.f};
        d = __builtin_amdgcn_mfma_scale_f32_16x16x128_f8f6f4(av, bv, d, 4, 0, 0, 0x7F7F7F7F, 0, 0x7F7F7F7F);
        const float val = __uint_as_float((unsigned)__builtin_amdgcn_readfirstlane((int)__float_as_uint(d[0])));
        const unsigned long long m_lo = __ballot(val == cand_lo), m_hi = __ballot(val == cand_hi);
        const unsigned q = m_lo ? (unsigned)__builtin_ctzll(m_lo) : (m_hi ? 64u + (unsigned)__builtin_ctzll(m_hi) : (unsigned)p);
        if (lane == 0) PI[p] = (unsigned char)q;
    }
}
__device__ __forceinline__ void phase_prologue(const Params& P, float* smem) {
    const int tid = otid(P.wv), gtid = blockIdx.x * NTH + tid, gnth = gridDim.x * NTH;
    calibrate_mx(P);
    rope_table(P, gtid, gnth);
    convert_bf16(P.x, (bf16_t*)P.out, (size_t)T * DM, gtid, gnth);
    convert_bf16(P.peer_sub_keys, (bf16_t*)(P.ws + WS_SKB), (size_t)2 * 8 * 2 * 128 * 128, gtid, gnth);
    for (int i = gtid; i < 2 * 2 * 4 * 4096; i += gnth) {
        const int ii = i & 63, jj = (i >> 6) & 63, blk = (i >> 12) & 3, gt = (i >> 14) & 1, l = i >> 15;
        const float* src = (gt == 0) ? P.lru_w_r : P.lru_w_i;
        ((bf16_t*)(P.ws + WS_WLRU))[i] = f2bf(src[((size_t)l * 4 + blk) * 4096 + ii * 64 + jj]);
    }
    constexpr int I_INA = 16 * 3, I_INB = 16 * 5, I_INC = 16, I_OUT = 64, I_Q = 128, I_G = 64, I_PJ = 16, I_L = I_INA + I_INB + I_INC + I_OUT + I_Q + I_G + I_PJ;
    for (int it = blockIdx.x; it < 2 * I_L; it += gridDim.x) {
        const int l = it / I_L; int r = it % I_L;
        const float* win = P.w_in + (size_t)l * DM * INC; bf16_t* wint = (bf16_t*)(P.ws + WS_WIN) + (size_t)l * HP * DM;
        if (r < I_INA) { transpose_item4(win, DM, INC, 0, wint, 0, 3, r, smem, tid); continue; } r -= I_INA;
        if (r < I_INB) { transpose_item4(win, DM, INC, 784, wint, 768, 5, r, smem, tid); continue; } r -= I_INB;
        if (r < I_INC) { transpose_item(win, DM, INC, 768, 16, (bf16_t*)(P.ws + WS_WA) + (size_t)l * 64 * DM, 0, 1, r, smem, tid); continue; } r -= I_INC;
        if (r < I_OUT) { transpose_item4(P.w_out + (size_t)l * DM * DM, DM, DM, 0, (bf16_t*)(P.ws + WS_WOUT) + (size_t)l * DM * DM, 0, 4, r, smem, tid); continue; } r -= I_OUT;
        if (r < I_Q) { transpose_item4(P.peer_w_q + (size_t)l * DM * 2048, DM, 2048, 0, (bf16_t*)(P.ws + WS_WQG) + (size_t)l * 3072 * DM, 0, 8, r, smem, tid); continue; } r -= I_Q;
        if (r < I_G) { transpose_item4(P.ple_w_gate + (size_t)l * DM * DM, DM, DM, 0, (bf16_t*)(P.ws + WS_WQG) + (size_t)l * 3072 * DM, 2048, 4, r, smem, tid); continue; } r -= I_G;
        transpose_item4(P.ple_w_proj + (size_t)l * 256 * DM, 256, DM, 0, (bf16_t*)(P.ws + WS_WPJ) + (size_t)l * DM * 256, 0, 4, r, smem, tid);
    }
}

__device__ __forceinline__ void alow_item(const Params& P, int layer, int item) {
    const bf16_t* XB = (const bf16_t*)P.out;
    const bf16_t* WA = (const bf16_t*)(P.ws + WS_WA) + (size_t)layer * 64 * DM;
    bf16_t* AL = (bf16_t*)(P.ws + WS_AL);
    const int tid = otid(P.wv), lane = tid & 63, w = tid >> 6, r16 = lane & 15, g = lane >> 4;
    const size_t tok0 = (size_t)item * 128 + 16 * w;
    const bf16_t* ap = XB + (tok0 + r16) * DM + 8 * g;
    const bf16_t* bp = WA + (size_t)r16 * DM + 8 * g;
    f32x4_t acc = (f32x4_t){0.f, 0.f, 0.f, 0.f};
#pragma unroll 8
    for (int ks = 0; ks < 32; ++ks) {
        const bf16x8_t af = *(const bf16x8_t*)(ap + 32 * ks), bfv = *(const bf16x8_t*)(bp + 32 * ks);
        acc = __builtin_amdgcn_mfma_f32_16x16x32_bf16(af, bfv, acc, 0, 0, 0);
    }
#pragma unroll
    for (int rg = 0; rg < 4; ++rg) AL[(tok0 + 4 * g + rg) * 16 + r16] = f2bf(acc[rg]);
}

constexpr int GLW = 1024, GLR = 3584;
__device__ __forceinline__ float fast_log_sigmoid(float z) {
    const float e = __builtin_amdgcn_exp2f(-fabsf(z) * 1.4426950408889634f);
    return fminf(z, 0.f) - __builtin_amdgcn_logf(1.f + e) * 0.6931471805599453f;
}
__device__ __forceinline__ void gla_pre_item(const Params& P, int layer, float* sm, int item) {
    const int bh = item >> 5, hd = bh & 3, b = bh >> 2, seg = item & 31;
    const bf16_t* H = (const bf16_t*)(P.ws + WS_H);
    bf16_t* QT = (bf16_t*)(P.ws + WS_GQT);
    bf16_t* KT = (bf16_t*)(P.ws + WS_GKT);
    bf16_t* VT = (bf16_t*)(P.ws + WS_GVT);
    float* DS = (float*)(P.ws + WS_GDS);
    float* DEC = (float*)(P.ws + WS_GDEC);
    float* GS = (float*)(P.ws + WS_GS);
    float* GD = (float*)(P.ws + WS_GD);
    const int tid = otid(P.wv), lane = tid & 63, w = __builtin_amdgcn_readfirstlane(tid >> 6), r16 = lane & 15, g = lane >> 4;
    const int chunk = seg * 8 + w;
    const size_t tok = (size_t)b * SEQ + (size_t)chunk * 64 + lane;
    const bf16_t* hrow = H + tok * HP;
    u32x4_t a0, a1, wq4[4], wk4[4], wv8[8];
    { const bf16_t* alr = (const bf16_t*)(P.ws + WS_AL) + tok * 16; a0 = *(const u32x4_t*)alr; a1 = *(const u32x4_t*)(alr + 8); }
#pragma unroll
    for (int j = 0; j < 4; ++j) { wq4[j] = *(const u32x4_t*)(hrow + C_GQ + hd * 32 + j * 8); wk4[j] = *(const u32x4_t*)(hrow + C_GK + hd * 32 + j * 8); }
#pragma unroll
    for (int j = 0; j < 8; ++j) wv8[j] = *(const u32x4_t*)(hrow + C_GV + hd * 64 + j * 8);
    { const int r = tid >> 5, d = tid & 31; sm[tid] = P.gla_w_a2[layer * 2048 + r * 128 + hd * 32 + d]; }
    if (tid < 32) sm[512 + tid] = P.gla_b_a[layer * 128 + hd * 32 + tid];
    __syncthreads();
    float bc[32];
    {
        float al[16];
        {
          al[0] = bflo(a0.x); al[1] = bfhi(a0.x); al[2] = bflo(a0.y); al[3] = bfhi(a0.y); al[4] = bflo(a0.z); al[5] = bfhi(a0.z); al[6] = bflo(a0.w); al[7] = bfhi(a0.w);
          al[8] = bflo(a1.x); al[9] = bfhi(a1.x); al[10] = bflo(a1.y); al[11] = bfhi(a1.y); al[12] = bflo(a1.z); al[13] = bfhi(a1.z); al[14] = bflo(a1.w); al[15] = bfhi(a1.w); }
#pragma unroll
        for (int d4 = 0; d4 < 8; ++d4) {
            float4 z = *(const float4*)(sm + 512 + d4 * 4);
#pragma unroll
            for (int r = 0; r < 16; ++r) { const float4 wv = *(const float4*)(sm + r * 32 + d4 * 4); z.x += al[r] * wv.x; z.y += al[r] * wv.y; z.z += al[r] * wv.z; z.w += al[r] * wv.w; }
            bc[d4 * 4 + 0] = fast_log_sigmoid(z.x) * 0.0625f; bc[d4 * 4 + 1] = fast_log_sigmoid(z.y) * 0.0625f;
            bc[d4 * 4 + 2] = fast_log_sigmoid(z.z) * 0.0625f; bc[d4 * 4 + 3] = fast_log_sigmoid(z.w) * 0.0625f;
        }
    }
#pragma unroll
    for (int d = 0; d < 32; ++d) bc[d] = wave_prefix_sum(bc[d]);
    bf16_t* khT = (bf16_t*)(sm + GLW + w * GLR);
    bf16_t* vT = khT + 32 * 72;
    {
        float qv[32], kv[32];
#pragma unroll
        for (int j = 0; j < 4; ++j) {
            const u32x4_t wq = wq4[j], wk = wk4[j];
            qv[j * 8 + 0] = bflo(wq.x); qv[j * 8 + 1] = bfhi(wq.x); qv[j * 8 + 2] = bflo(wq.y); qv[j * 8 + 3] = bfhi(wq.y);
            qv[j * 8 + 4] = bflo(wq.z); qv[j * 8 + 5] = bfhi(wq.z); qv[j * 8 + 6] = bflo(wq.w); qv[j * 8 + 7] = bfhi(wq.w);
            kv[j * 8 + 0] = bflo(wk.x); kv[j * 8 + 1] = bfhi(wk.x); kv[j * 8 + 2] = bflo(wk.y); kv[j * 8 + 3] = bfhi(wk.y);
            kv[j * 8 + 4] = bflo(wk.z); kv[j * 8 + 5] = bfhi(wk.z); kv[j * 8 + 6] = bflo(wk.w); kv[j * 8 + 7] = bfhi(wk.w);
        }
        float kh[32];
#pragma unroll
        for (int d = 0; d < 32; ++d) {
            const float bl = __uint_as_float((unsigned)__builtin_amdgcn_readlane((int)__float_as_uint(bc[d]), 63));
            const float eb = __builtin_amdgcn_exp2f(bc[d] * 1.4426950408889634f), enb = __builtin_amdgcn_exp2f(-bc[d] * 1.4426950408889634f);
            kh[d] = kv[d] * __builtin_amdgcn_exp2f((bl - bc[d]) * 1.4426950408889634f);
            qv[d] = qv[d] * 0.17677669529663687f * eb; kv[d] = kv[d] * enb;
        }
#pragma unroll
        for (int j = 0; j < 4; ++j) {
            u32x4_t wq, wk;
            wq.x = pack2bf(qv[j * 8 + 0], qv[j * 8 + 1]); wq.y = pack2bf(qv[j * 8 + 2], qv[j * 8 + 3]); wq.z = pack2bf(qv[j * 8 + 4], qv[j * 8 + 5]); wq.w = pack2bf(qv[j * 8 + 6], qv[j * 8 + 7]);
            wk.x = pack2bf(kv[j * 8 + 0], kv[j * 8 + 1]); wk.y = pack2bf(kv[j * 8 + 2], kv[j * 8 + 3]); wk.z = pack2bf(kv[j * 8 + 4], kv[j * 8 + 5]); wk.w = pack2bf(kv[j * 8 + 6], kv[j * 8 + 7]);
            *(u32x4_t*)(QT + ((size_t)hd * T + tok) * 32 + j * 8) = wq; *(u32x4_t*)(KT + ((size_t)hd * T + tok) * 32 + j * 8) = wk;
        }
#pragma unroll
        for (int d = 0; d < 32; ++d) khT[d * 72 + lane] = f2bf(kh[d]);
    }
    bf16_t* VTc = VT + ((size_t)bh * 256 + chunk) * 4096;
#pragma unroll
    for (int j = 0; j < 8; ++j) {
        const u32x4_t wv = wv8[j];
        const unsigned ww[4] = {wv.x, wv.y, wv.z, wv.w};
#pragma unroll
        for (int q = 0; q < 4; ++q) {
            const bf16_t lo = (bf16_t)(ww[q] & 0xffffu), hi = (bf16_t)(ww[q] >> 16);
            const int dv = j * 8 + q * 2;
            vT[dv * 72 + lane] = lo; vT[(dv + 1) * 72 + lane] = hi;
        }
    }
#pragma unroll
    for (int k = 0; k < 8; ++k) {
        const int dv = 8 * k + (lane >> 3);
        *(u32x4_t*)(VTc + dv * 64 + (lane & 7) * 8) = *(const u32x4_t*)(vT + dv * 72 + (lane & 7) * 8);
    }
    if (lane == 63) {
        float* dg = DEC + ((size_t)bh * 256 + chunk) * 32;
#pragma unroll
        for (int d = 0; d < 32; ++d) { const float e = __builtin_amdgcn_exp2f(bc[d] * 1.4426950408889634f); dg[d] = e; sm[544 + w * 32 + d] = e; }
    }
    f32x4_t acc[2][4];
#pragma unroll
    for (int mt = 0; mt < 2; ++mt)
#pragma unroll
        for (int nt = 0; nt < 4; ++nt) acc[mt][nt] = (f32x4_t){0.f, 0.f, 0.f, 0.f};
#pragma unroll
    for (int ks = 0; ks < 2; ++ks) {
        bf16x8_t af[2], bfv[4];
#pragma unroll
        for (int mt = 0; mt < 2; ++mt) af[mt] = *(const bf16x8_t*)(khT + (16 * mt + r16) * 72 + 32 * ks + 8 * g);
#pragma unroll
        for (int nt = 0; nt < 4; ++nt) bfv[nt] = *(const bf16x8_t*)(vT + (16 * nt + r16) * 72 + 32 * ks + 8 * g);
#pragma unroll
        for (int mt = 0; mt < 2; ++mt)
#pragma unroll
            for (int nt = 0; nt < 4; ++nt) acc[mt][nt] = __builtin_amdgcn_mfma_f32_16x16x32_bf16(af[mt], bfv[nt], acc[mt][nt], 0, 0, 0);
    }
    float* DSc = DS + ((size_t)bh * 256 + chunk) * 2048;
    float* dsl = sm + GLW + w * GLR;
#pragma unroll
    for (int mt = 0; mt < 2; ++mt)
#pragma unroll
        for (int nt = 0; nt < 4; ++nt)
#pragma unroll
            for (int rg = 0; rg < 4; ++rg) { const int idx = (16 * mt + 4 * g + rg) * 64 + 16 * nt + r16; dsl[idx] = acc[mt][nt][rg]; }
#pragma unroll
    for (int k = 0; k < 8; ++k) *(float4*)(DSc + k * 256 + lane * 4) = *(const float4*)(dsl + k * 256 + lane * 4);
    __syncthreads();
    {
        const int d = tid >> 4, v4 = (tid & 15) * 4;
        float4 S4 = make_float4(0.f, 0.f, 0.f, 0.f); float pd = 1.f;
#pragma unroll
        for (int c = 0; c < 8; ++c) {
            const float e = sm[544 + c * 32 + d];
            const float4 dv4 = *(const float4*)(sm + GLW + c * GLR + d * 64 + v4);
            S4.x = e * S4.x + dv4.x; S4.y = e * S4.y + dv4.y; S4.z = e * S4.z + dv4.z; S4.w = e * S4.w + dv4.w; pd *= e;
        }
        *(float4*)(GS + (size_t)item * 2048 + d * 64 + v4) = S4;
        if ((tid & 15) == 0) GD[item * 32 + d] = pd;
    }
    __syncthreads();
}
__device__ __forceinline__ void gla_out_item(const Params& P, int layer, float* sm, int item) {
    const int bh = item >> 5, hd = bh & 3, b = bh >> 2, seg = item & 31;
    const bf16_t* H = (const bf16_t*)(P.ws + WS_H);
    bf16_t* O = (bf16_t*)(P.ws + WS_O);
    const bf16_t* QT = (const bf16_t*)(P.ws + WS_GQT);
    const bf16_t* KT = (const bf16_t*)(P.ws + WS_GKT);
    const bf16_t* VT = (const bf16_t*)(P.ws + WS_GVT);
    const float* DS = (const float*)(P.ws + WS_GDS);
    const float* DEC = (const float*)(P.ws + WS_GDEC);
    const float* GS = (const float*)(P.ws + WS_GS);
    const float* GD = (const float*)(P.ws + WS_GD);
    const int tid = otid(P.wv), lane = tid & 63, w = __builtin_amdgcn_readfirstlane(tid >> 6), r16 = lane & 15, g = lane >> 4;
    const int chunk = seg * 8 + w;
    const size_t t0 = (size_t)b * SEQ + (size_t)chunk * 64;
    bf16x8_t aq[4], bk[4];
#pragma unroll
    for (int mt = 0; mt < 4; ++mt) {
        aq[mt] = *(const bf16x8_t*)(QT + ((size_t)hd * T + t0 + 16 * mt + r16) * 32 + 8 * g);
        bk[mt] = *(const bf16x8_t*)(KT + ((size_t)hd * T + t0 + 16 * mt + r16) * 32 + 8 * g);
    }
    const bf16_t* VTc = VT + ((size_t)bh * 256 + chunk) * 4096;
    bf16x8_t vf[4][2];
#pragma unroll
    for (int nt = 0; nt < 4; ++nt)
#pragma unroll
        for (int ks = 0; ks < 2; ++ks) vf[nt][ks] = *(const bf16x8_t*)(VTc + (16 * nt + r16) * 64 + 32 * ks + 8 * g);
    u32x4_t gq[8];
#pragma unroll
    for (int k = 0; k < 8; ++k) gq[k] = *(const u32x4_t*)(H + (t0 + 8 * k + (lane >> 3)) * HP + C_GG + hd * 64 + (lane & 7) * 8);
    {
        const int d = tid >> 4, v4 = (tid & 15) * 4;
        float4 S4 = make_float4(0.f, 0.f, 0.f, 0.f);
#pragma unroll 8
        for (int sp = 0; sp < seg; ++sp) {
            const int it = (item & ~31) + sp;
            const float e = GD[it * 32 + d];
            const float4 sv = *(const float4*)(GS + (size_t)it * 2048 + d * 64 + v4);
            S4.x = e * S4.x + sv.x; S4.y = e * S4.y + sv.y; S4.z = e * S4.z + sv.z; S4.w = e * S4.w + sv.w;
        }
#pragma unroll
        for (int c = 0; c < 8; ++c) {
            bf16_t* ST = (bf16_t*)(sm + GLW + c * GLR) + 64 * 72;
            ST[(v4 + 0) * 40 + d] = f2bf(S4.x); ST[(v4 + 1) * 40 + d] = f2bf(S4.y); ST[(v4 + 2) * 40 + d] = f2bf(S4.z); ST[(v4 + 3) * 40 + d] = f2bf(S4.w);
            const size_t ci = (size_t)bh * 256 + seg * 8 + c;
            const float e = DEC[ci * 32 + d];
            const float4 dv4 = *(const float4*)(DS + ci * 2048 + d * 64 + v4);
            S4.x = e * S4.x + dv4.x; S4.y = e * S4.y + dv4.y; S4.z = e * S4.z + dv4.z; S4.w = e * S4.w + dv4.w;
        }
    }
    __syncthreads();
    bf16_t* attS = (bf16_t*)(sm + GLW + w * GLR);
    const bf16_t* ST = attS + 64 * 72;
#pragma unroll
    for (int mt = 0; mt < 4; ++mt)
#pragma unroll
        for (int nt = 0; nt < 4; ++nt) {
            if (nt <= mt) {
                f32x4_t at = (f32x4_t){0.f, 0.f, 0.f, 0.f};
                at = __builtin_amdgcn_mfma_f32_16x16x32_bf16(aq[mt], bk[nt], at, 0, 0, 0);
#pragma unroll
                for (int rg = 0; rg < 4; ++rg) {
                    float v = at[rg];
                    if (nt == mt && r16 > 4 * g + rg) v = 0.f;
                    attS[(16 * mt + 4 * g + rg) * 72 + 16 * nt + r16] = f2bf(v);
                }
            } else if (nt == mt + 1 && (mt & 1) == 0) {
#pragma unroll
                for (int rg = 0; rg < 4; ++rg) attS[(16 * mt + 4 * g + rg) * 72 + 16 * nt + r16] = (bf16_t)0;
            }
        }
    f32x4_t acc[4][4];
#pragma unroll
    for (int mt = 0; mt < 4; ++mt)
#pragma unroll
        for (int nt = 0; nt < 4; ++nt) acc[mt][nt] = (f32x4_t){0.f, 0.f, 0.f, 0.f};
    bf16x8_t sf[4];
#pragma unroll
    for (int nt = 0; nt < 4; ++nt) sf[nt] = *(const bf16x8_t*)(ST + (16 * nt + r16) * 40 + 8 * g);
#pragma unroll
    for (int mt = 0; mt < 4; ++mt) {
#pragma unroll
        for (int ks = 0; ks < 2; ++ks) {
            if (ks == 0 || mt >= 2) {
                const bf16x8_t af = *(const bf16x8_t*)(attS + (16 * mt + r16) * 72 + 32 * ks + 8 * g);
#pragma unroll
                for (int nt = 0; nt < 4; ++nt) acc[mt][nt] = __builtin_amdgcn_mfma_f32_16x16x32_bf16(af, vf[nt][ks], acc[mt][nt], 0, 0, 0);
            }
        }
#pragma unroll
        for (int nt = 0; nt < 4; ++nt) acc[mt][nt] = __builtin_amdgcn_mfma_f32_16x16x32_bf16(aq[mt], sf[nt], acc[mt][nt], 0, 0, 0);
    }
    float nw[4];
#pragma unroll
    for (int nt = 0; nt < 4; ++nt) nw[nt] = P.gla_norm_w[layer * 64 + 16 * nt + r16];
#pragma unroll
    for (int mt = 0; mt < 4; ++mt)
#pragma unroll
        for (int rg = 0; rg < 4; ++rg) {
            float ss = 0.f;
#pragma unroll
            for (int nt = 0; nt < 4; ++nt) ss += acc[mt][nt][rg] * acc[mt][nt][rg];
            ss += __shfl_xor(ss, 1); ss += __shfl_xor(ss, 2); ss += __shfl_xor(ss, 4); ss += __shfl_xor(ss, 8);
            const float r = rsqrtf(ss * (1.f / 64.f) + 1e-6f);
#pragma unroll
            for (int nt = 0; nt < 4; ++nt) attS[(16 * mt + 4 * g + rg) * 72 + 16 * nt + r16] = f2bf(acc[mt][nt][rg] * r * nw[nt]);
        }
#pragma unroll
    for (int k = 0; k < 8; ++k) {
        const int tk = 8 * k + (lane >> 3);
        const u32x4_t yq = *(const u32x4_t*)(attS + tk * 72 + (lane & 7) * 8);
        const unsigned yw[4] = {yq.x, yq.y, yq.z, yq.w}, gw[4] = {gq[k].x, gq[k].y, gq[k].z, gq[k].w};
        unsigned ow[4];
#pragma unroll
        for (int e = 0; e < 4; ++e) {
            const float g0 = bflo(gw[e]), g1 = bfhi(gw[e]);
            ow[e] = pack2bf(bflo(yw[e]) * (g0 * sigmoid_f(g0)), bfhi(yw[e]) * (g1 * sigmoid_f(g1)));
        }
        u32x4_t oq; oq.x = ow[0]; oq.y = ow[1]; oq.z = ow[2]; oq.w = ow[3];
        *(u32x4_t*)(O + (t0 + tk) * DM + hd * 64 + (lane & 7) * 8) = oq;
    }
    __syncthreads();
}

typedef float f32x16_t __attribute__((ext_vector_type(16)));
typedef unsigned long long u64_t;
__device__ __forceinline__ void swa_item(const Params& P, int layer, float* smem, int item) {
    const int b = item >> 8, n = (item >> 1) & 127, kvh = item & 1;
    const bf16_t* H = (const bf16_t*)(P.ws + WS_H);
    bf16_t* O = (bf16_t*)(P.ws + WS_O);
    const float2* cs = (const float2*)(P.ws + WS_CS);
    bf16_t* Ks = (bf16_t*)smem;
    bf16_t* Vt = Ks + 256 * 72;
    const int tid = otid(P.wv), lane = tid & 63, w = tid >> 6;
    const size_t blk0 = (size_t)b * SEQ + (size_t)n * 128;
    const int jstart = (n == 0) ? 128 : 0;
    const int g = w >> 1, qh = w & 1, head = kvh * 4 + g, ql = lane & 31, h32 = lane >> 5;
    const float sink2 = P.swa_sinks[layer * 8 + head] * 1.4426950408889634f;
    bf16x8_t qfa[2][4];
#pragma unroll
    for (int qt = 0; qt < 2; ++qt) {
        const size_t tq = blk0 + 64 * qh + 32 * qt + ql;
        const bf16_t* qrow = H + tq * HP + C_SQ + head * 64 + 8 * h32;
        float qa[4][8];
#pragma unroll
        for (int ks = 0; ks < 4; ++ks) {
            const u32x4_t w4 = *(const u32x4_t*)(qrow + 16 * ks);
            qa[ks][0] = bflo(w4.x); qa[ks][1] = bfhi(w4.x); qa[ks][2] = bflo(w4.y); qa[ks][3] = bfhi(w4.y);
            qa[ks][4] = bflo(w4.z); qa[ks][5] = bfhi(w4.z); qa[ks][6] = bflo(w4.w); qa[ks][7] = bfhi(w4.w);
        }
        const float SC = 0.125f * 1.4426950408889634f;
#pragma unroll
        for (int ks = 0; ks < 2; ++ks)
#pragma unroll
            for (int j = 0; j < 8; ++j) {
                const float2 c = cs[tq * 32 + 16 * ks + 8 * h32 + j];
                const float q1 = qa[ks][j], q2 = qa[ks + 2][j];
                qa[ks][j] = (q1 * c.x - q2 * c.y) * SC; qa[ks + 2][j] = (q2 * c.x + q1 * c.y) * SC;
            }
#pragma unroll
        for (int ks = 0; ks < 4; ++ks) {
            u32x4_t pk; pk.x = pack2bf(qa[ks][0], qa[ks][1]); pk.y = pack2bf(qa[ks][2], qa[ks][3]); pk.z = pack2bf(qa[ks][4], qa[ks][5]); pk.w = pack2bf(qa[ks][6], qa[ks][7]);
            qfa[qt][ks] = __builtin_bit_cast(bf16x8_t, pk);
        }
    }
#pragma unroll
    for (int it = 0; it < 2; ++it) {
        const int i = tid + it * NTH, j = i >> 2, sg = i & 3;
        u32x4_t o1 = {0u, 0u, 0u, 0u}, o2 = {0u, 0u, 0u, 0u};
        if (j >= jstart) {
            const size_t tk = blk0 - 128 + j;
            const bf16_t* hrow = H + tk * HP + C_SK + kvh * 64 + sg * 8;
            const u32x4_t w1 = *(const u32x4_t*)hrow, w2 = *(const u32x4_t*)(hrow + 32);
            const float4* cp = (const float4*)(cs + tk * 32 + sg * 8);
            const float4 c01 = cp[0], c23 = cp[1], c45 = cp[2], c67 = cp[3];
            const float k1[8] = {bflo(w1.x), bfhi(w1.x), bflo(w1.y), bfhi(w1.y), bflo(w1.z), bfhi(w1.z), bflo(w1.w), bfhi(w1.w)};
            const float k2[8] = {bflo(w2.x), bfhi(w2.x), bflo(w2.y), bfhi(w2.y), bflo(w2.z), bfhi(w2.z), bflo(w2.w), bfhi(w2.w)};
            const float cc[8] = {c01.x, c01.z, c23.x, c23.z, c45.x, c45.z, c67.x, c67.z}, sn[8] = {c01.y, c01.w, c23.y, c23.w, c45.y, c45.w, c67.y, c67.w};
            float r1[8], r2[8];
#pragma unroll
            for (int e = 0; e < 8; ++e) { r1[e] = k1[e] * cc[e] - k2[e] * sn[e]; r2[e] = k2[e] * cc[e] + k1[e] * sn[e]; }
            o1.x = pack2bf(r1[0], r1[1]); o1.y = pack2bf(r1[2], r1[3]); o1.z = pack2bf(r1[4], r1[5]); o1.w = pack2bf(r1[6], r1[7]);
            o2.x = pack2bf(r2[0], r2[1]); o2.y = pack2bf(r2[2], r2[3]); o2.z = pack2bf(r2[4], r2[5]); o2.w = pack2bf(r2[6], r2[7]);
        }
        *(u32x4_t*)(Ks + j * 72 + sg * 8) = o1; *(u32x4_t*)(Ks + j * 72 + 32 + sg * 8) = o2;
    }
    for (int i = tid; i < 256 * 16; i += NTH) {
        const int j = i >> 4, d4 = i & 15;
        u32x2_t wv = {0u, 0u};
        if (j >= jstart) wv = *(const u32x2_t*)(H + (blk0 - 128 + j) * HP + C_SV + kvh * 64 + d4 * 4);
        Vt[(d4 * 4 + 0) * 260 + j] = (bf16_t)(wv.x & 0xffffu); Vt[(d4 * 4 + 1) * 260 + j] = (bf16_t)(wv.x >> 16);
        Vt[(d4 * 4 + 2) * 260 + j] = (bf16_t)(wv.y & 0xffffu); Vt[(d4 * 4 + 3) * 260 + j] = (bf16_t)(wv.y >> 16);
    }
    __syncthreads();
#pragma unroll 1
    for (int qt = 0; qt < 2; ++qt) {
        const int qi = 64 * qh + 32 * qt + ql;
        const size_t tq = blk0 + qi;
        bf16x8_t qf[4];
#pragma unroll
        for (int ks = 0; ks < 4; ++ks) qf[ks] = qt ? qfa[1][ks] : qfa[0][ks];
        f32x16_t st[5];
#pragma unroll
        for (int t5 = 0; t5 < 5; ++t5) {
            st[t5] = (f32x16_t){0.f, 0.f, 0.f, 0.f, 0.f, 0.f, 0.f, 0.f, 0.f, 0.f, 0.f, 0.f, 0.f, 0.f, 0.f, 0.f};
            const bf16_t* kp = Ks + (64 * qh + 32 * (qt + t5) + ql) * 72 + 8 * h32;
#pragma unroll
            for (int ks = 0; ks < 4; ++ks) {
                const bf16x8_t kf = *(const bf16x8_t*)(kp + 16 * ks);
                st[t5] = __builtin_amdgcn_mfma_f32_32x32x16_bf16(kf, qf[ks], st[t5], 0, 0, 0);
            }
        }
        const int dl = 4 * h32 - ql;
        float mx = -INFINITY;
#pragma unroll
        for (int r = 0; r < 16; ++r) {
            const int off = (r & 3) + 8 * (r >> 2);
            st[0][r] = (off + dl >= 1) ? st[0][r] : -INFINITY;
            st[4][r] = (off + dl <= 0) ? st[4][r] : -INFINITY;
        }
        if (n == 0) {
#pragma unroll
            for (int t5 = 0; t5 < 5; ++t5)
#pragma unroll
                for (int r = 0; r < 16; ++r) {
                    const int kj = 64 * qh + 32 * (qt + t5) + (r & 3) + 8 * (r >> 2) + 4 * h32;
                    st[t5][r] = (kj >= 128) ? st[t5][r] : -INFINITY;
                }
        }
#pragma unroll
        for (int t5 = 0; t5 < 5; ++t5)
#pragma unroll
            for (int r = 0; r < 16; ++r) mx = fmaxf(mx, st[t5][r]);
        mx = fmaxf(mx, __shfl_xor(mx, 32));
        const float m = fmaxf(mx, sink2);
        float l = 0.f;
#pragma unroll
        for (int t5 = 0; t5 < 5; ++t5)
#pragma unroll
            for (int r = 0; r < 16; ++r) { const float pj = __builtin_amdgcn_exp2f(st[t5][r] - m); st[t5][r] = pj; l += pj; }
        l += __shfl_xor(l, 32);
        l += __builtin_amdgcn_exp2f(sink2 - m);
        f32x16_t ot[2];
        ot[0] = (f32x16_t){0.f, 0.f, 0.f, 0.f, 0.f, 0.f, 0.f, 0.f, 0.f, 0.f, 0.f, 0.f, 0.f, 0.f, 0.f, 0.f}; ot[1] = ot[0];
#pragma unroll
        for (int t5 = 0; t5 < 5; ++t5)
#pragma unroll
            for (int sx = 0; sx < 2; ++sx) {
                u32x4_t pk; pk.x = pack2bf(st[t5][8 * sx + 0], st[t5][8 * sx + 1]); pk.y = pack2bf(st[t5][8 * sx + 2], st[t5][8 * sx + 3]);
                pk.z = pack2bf(st[t5][8 * sx + 4], st[t5][8 * sx + 5]); pk.w = pack2bf(st[t5][8 * sx + 6], st[t5][8 * sx + 7]);
                const bf16x8_t pf = __builtin_bit_cast(bf16x8_t, pk);
                const int kb = 64 * qh + 32 * (qt + t5) + 16 * sx + 4 * h32;
#pragma unroll
                for (int dt = 0; dt < 2; ++dt) {
                    const bf16_t* vp = Vt + (32 * dt + ql) * 260 + kb;
                    const u64_t v0 = *(const u64_t*)vp, v1 = *(const u64_t*)(vp + 8);
                    u32x4_t vk; vk.x = (unsigned)v0; vk.y = (unsigned)(v0 >> 32); vk.z = (unsigned)v1; vk.w = (unsigned)(v1 >> 32);
                    ot[dt] = __builtin_amdgcn_mfma_f32_32x32x16_bf16(__builtin_bit_cast(bf16x8_t, vk), pf, ot[dt], 0, 0, 0);
                }
            }
        const float inv = 1.f / l;
        bf16_t* orow = O + tq * DM + 256 + head * 64 + 4 * h32;
#pragma unroll
        for (int dt = 0; dt < 2; ++dt)
#pragma unroll
            for (int r4 = 0; r4 < 4; ++r4) {
                u32x2_t ov; ov.x = pack2bf(ot[dt][4 * r4 + 0] * inv, ot[dt][4 * r4 + 1] * inv); ov.y = pack2bf(ot[dt][4 * r4 + 2] * inv, ot[dt][4 * r4 + 3] * inv);
                *(u32x2_t*)(orow + 32 * dt + 8 * r4) = ov;
            }
    }
    __syncthreads();
}

__device__ __forceinline__ void lru1_item(const Params& P, int layer, float* smem, int item) {
    const int b = item >> 7, ch = item & 127;
    const bf16_t* H = (const bf16_t*)(P.ws + WS_H);
    unsigned* LAU = (unsigned*)(P.ws + WS_LA);
    float* AGP = (float*)(P.ws + WS_AGP);
    float* AGH = (float*)(P.ws + WS_AGH);
    bf16_t* Xs = (bf16_t*)smem;
    const int tid = otid(P.wv);
    const size_t t0 = (size_t)b * SEQ + (size_t)ch * 128;
    const int lane = tid & 63, w = tid >> 6, blk = w >> 1, th = w & 1, r16 = lane & 15, g = lane >> 4;
    bf16x8_t wf[2][4][2];
    {
        const bf16_t* wb = (const bf16_t*)(P.ws + WS_WLRU) + ((size_t)(layer * 2) * 4 + blk) * 4096 + r16 * 64 + 8 * g;
#pragma unroll
        for (int gt = 0; gt < 2; ++gt)
#pragma unroll
            for (int nt = 0; nt < 4; ++nt)
#pragma unroll
                for (int ks = 0; ks < 2; ++ks) wf[gt][nt][ks] = *(const bf16x8_t*)(wb + (size_t)gt * 4 * 4096 + nt * 16 * 64 + ks * 32);
    }
    float br[4], bi[4], lsl[4];
#pragma unroll
    for (int nt = 0; nt < 4; ++nt) {
        const int c = blk * 64 + 16 * nt + r16;
        br[nt] = P.lru_b_r[layer * 256 + c]; bi[nt] = P.lru_b_i[layer * 256 + c];
        lsl[nt] = 8.f * log_sigmoid_f(P.lru_lambda[layer * 256 + c]);
    }
    {
        const int cg = tid & 31, tq = tid >> 5;
        const float* cw = P.lru_conv_w + layer * 4 * 256 + cg * 8;
        float wc[4][8], bb[8];
#pragma unroll
        for (int d = 0; d < 4; ++d) {
            const float4 a = *(const float4*)(cw + d * 256), c4 = *(const float4*)(cw + d * 256 + 4);
            wc[d][0] = a.x; wc[d][1] = a.y; wc[d][2] = a.z; wc[d][3] = a.w; wc[d][4] = c4.x; wc[d][5] = c4.y; wc[d][6] = c4.z; wc[d][7] = c4.w;
        }
        { const float4 a = *(const float4*)(P.lru_conv_b + layer * 256 + cg * 8), c4 = *(const float4*)(P.lru_conv_b + layer * 256 + cg * 8 + 4);
          bb[0] = a.x; bb[1] = a.y; bb[2] = a.z; bb[3] = a.w; bb[4] = c4.x; bb[5] = c4.y; bb[6] = c4.z; bb[7] = c4.w; }
#pragma unroll 4
        for (int k = 0; k < 8; ++k) {
            const int tt = tq + 16 * k, tloc = ch * 128 + tt;
            const bf16_t* hp = H + (t0 + tt) * HP + C_RR + cg * 8;
            const u32x4_t z4 = {0u, 0u, 0u, 0u};
            u32x4_t rr[4];
            rr[3] = *(const u32x4_t*)hp;
            rr[2] = (tloc >= 1) ? *(const u32x4_t*)(hp - 1 * HP) : z4;
            rr[1] = (tloc >= 2) ? *(const u32x4_t*)(hp - 2 * HP) : z4;
            rr[0] = (tloc >= 3) ? *(const u32x4_t*)(hp - 3 * HP) : z4;
            float o[8];
#pragma unroll
            for (int e = 0; e < 8; ++e) o[e] = bb[e];
#pragma unroll
            for (int d = 0; d < 4; ++d) {
                const float xv[8] = {bflo(rr[d].x), bfhi(rr[d].x), bflo(rr[d].y), bfhi(rr[d].y), bflo(rr[d].z), bfhi(rr[d].z), bflo(rr[d].w), bfhi(rr[d].w)};
#pragma unroll
                for (int e = 0; e < 8; ++e) o[e] += wc[d][e] * xv[e];
            }
            u32x4_t pk; pk.x = pack2bf(o[0], o[1]); pk.y = pack2bf(o[2], o[3]); pk.z = pack2bf(o[4], o[5]); pk.w = pack2bf(o[6], o[7]);
            *(u32x4_t*)(Xs + tt * 264 + cg * 8) = pk;
        }
    }
    __syncthreads();
    float Pw[4], Hw[4];
#pragma unroll
    for (int nt = 0; nt < 4; ++nt) { Pw[nt] = 1.f; Hw[nt] = 0.f; }
#pragma unroll 1
    for (int mt = 0; mt < 4; ++mt) {
        const int trow = th * 64 + 16 * mt;
        f32x4_t ar[4], ai[4];
#pragma unroll
        for (int nt = 0; nt < 4; ++nt) { ar[nt] = (f32x4_t){0.f, 0.f, 0.f, 0.f}; ai[nt] = ar[nt]; }
#pragma unroll
        for (int ks = 0; ks < 2; ++ks) {
            const bf16x8_t af = *(const bf16x8_t*)(Xs + (trow + r16) * 264 + blk * 64 + 32 * ks + 8 * g);
#pragma unroll
            for (int nt = 0; nt < 4; ++nt) {
                ar[nt] = __builtin_amdgcn_mfma_f32_16x16x32_bf16(af, wf[0][nt][ks], ar[nt], 0, 0, 0);
                ai[nt] = __builtin_amdgcn_mfma_f32_16x16x32_bf16(af, wf[1][nt][ks], ai[nt], 0, 0, 0);
            }
        }
        float Pl[4], Hl[4];
#pragma unroll
        for (int nt = 0; nt < 4; ++nt) { Pl[nt] = 1.f; Hl[nt] = 0.f; }
#pragma unroll
        for (int rg = 0; rg < 4; ++rg) {
            const int tt = trow + 4 * g + rg;
            const size_t t = t0 + tt;
#pragma unroll
            for (int nt = 0; nt < 4; ++nt) {
                const int c = blk * 64 + 16 * nt + r16;
                const float r = sigmoid_f(ar[nt][rg] + br[nt]), ig = sigmoid_f(ai[nt][rg] + bi[nt]);
                const h2x_t lu = __builtin_amdgcn_cvt_pkrtz(lsl[nt] * r * 1.4426950408889634f, 0.f);
                const float la2 = (float)lu[0];
                const float av = __builtin_amdgcn_exp2f(la2);
                const float uf = __builtin_amdgcn_sqrtf(fmaxf(1.f - av * av, 0.f)) * (ig * bf2f(Xs[tt * 264 + c]));
                const h2x_t up = __builtin_amdgcn_cvt_pkrtz(la2, uf);
                const float uv = (float)up[1];
                LAU[t * 256 + c] = __builtin_bit_cast(unsigned, up);
                Pl[nt] *= av; Hl[nt] = av * Hl[nt] + uv;
            }
        }
#pragma unroll
        for (int nt = 0; nt < 4; ++nt) {
            float Pp = __shfl_xor(Pl[nt], 16), Hp = __shfl_xor(Hl[nt], 16);
            if (g & 1) { Hl[nt] = Pl[nt] * Hp + Hl[nt]; } else { Hl[nt] = Pp * Hl[nt] + Hp; }
            Pl[nt] *= Pp;
            Pp = __shfl_xor(Pl[nt], 32); Hp = __shfl_xor(Hl[nt], 32);
            if (g & 2) { Hl[nt] = Pl[nt] * Hp + Hl[nt]; } else { Hl[nt] = Pp * Hl[nt] + Hp; }
            Pl[nt] *= Pp;
            Hw[nt] = Pl[nt] * Hw[nt] + Hl[nt]; Pw[nt] *= Pl[nt];
        }
    }
    if (g == 0) {
#pragma unroll
        for (int nt = 0; nt < 4; ++nt) {
            const int c = blk * 64 + 16 * nt + r16;
            AGP[((size_t)b * 256 + ch * 2 + th) * 256 + c] = Pw[nt];
            AGH[((size_t)b * 256 + ch * 2 + th) * 256 + c] = Hw[nt];
        }
    }
    __syncthreads();
}

__device__ __forceinline__ void lru2_item(const Params& P, int layer, float* smem, int item) {
    const int b = item >> 7, ch = item & 127;
    const bf16_t* H = (const bf16_t*)(P.ws + WS_H);
    const unsigned* LAU = (const unsigned*)(P.ws + WS_LA);
    const float* AGP = (const float*)(P.ws + WS_AGP);
    const float* AGH = (const float*)(P.ws + WS_AGH);
    bf16_t* O = (bf16_t*)(P.ws + WS_O);
    const int tid = otid(P.wv), lane = tid & 63, w = tid >> 6;
    const size_t t0 = (size_t)b * SEQ + (size_t)ch * 128 + 16 * w;
    u32x4_t lau[16]; u32x2_t rgv[16];
#pragma unroll
    for (int i = 0; i < 16; ++i) {
        lau[i] = *(const u32x4_t*)(LAU + (t0 + i) * 256 + lane * 4);
        rgv[i] = *(const u32x2_t*)(H + (t0 + i) * HP + C_RG + lane * 4);
    }
    const int nsub = ch * 2;
    {
        const int per = (nsub + 7) >> 3, s0 = w * per, s1 = (s0 + per < nsub) ? s0 + per : nsub;
        float4 Pm = make_float4(1.f, 1.f, 1.f, 1.f), Hm = make_float4(0.f, 0.f, 0.f, 0.f);
#pragma unroll 8
        for (int sidx = s0; sidx < s1; ++sidx) {
            const float4 p4 = *(const float4*)(AGP + ((size_t)b * 256 + sidx) * 256 + lane * 4), h4 = *(const float4*)(AGH + ((size_t)b * 256 + sidx) * 256 + lane * 4);
            Hm.x = p4.x * Hm.x + h4.x; Hm.y = p4.y * Hm.y + h4.y; Hm.z = p4.z * Hm.z + h4.z; Hm.w = p4.w * Hm.w + h4.w;
            Pm.x *= p4.x; Pm.y *= p4.y; Pm.z *= p4.z; Pm.w *= p4.w;
        }
        *(float4*)(smem + (w * 2 + 0) * 256 + lane * 4) = Pm; *(float4*)(smem + (w * 2 + 1) * 256 + lane * 4) = Hm;
    }
    {
        float Pl[4] = {1.f, 1.f, 1.f, 1.f}, Hl[4] = {0.f, 0.f, 0.f, 0.f};
#pragma unroll
        for (int i = 0; i < 16; ++i)
#pragma unroll
            for (int j = 0; j < 4; ++j) {
                const unsigned q = lau[i][j];
                const h2x_t p = __builtin_bit_cast(h2x_t, q);
                const float a = __builtin_amdgcn_exp2f((float)p[0]);
                Hl[j] = a * Hl[j] + (float)p[1]; Pl[j] *= a;
            }
        *(float4*)(smem + 4096 + (w * 2 + 0) * 256 + lane * 4) = make_float4(Pl[0], Pl[1], Pl[2], Pl[3]);
        *(float4*)(smem + 4096 + (w * 2 + 1) * 256 + lane * 4) = make_float4(Hl[0], Hl[1], Hl[2], Hl[3]);
    }
    __syncthreads();
    float h[4] = {0.f, 0.f, 0.f, 0.f};
#pragma unroll
    for (int k = 0; k < 8; ++k) {
        const float4 p4 = *(const float4*)(smem + (k * 2 + 0) * 256 + lane * 4), h4 = *(const float4*)(smem + (k * 2 + 1) * 256 + lane * 4);
        h[0] = p4.x * h[0] + h4.x; h[1] = p4.y * h[1] + h4.y; h[2] = p4.z * h[2] + h4.z; h[3] = p4.w * h[3] + h4.w;
    }
    for (int k = 0; k < w; ++k) {
        const float4 p4 = *(const float4*)(smem + 4096 + (k * 2 + 0) * 256 + lane * 4), h4 = *(const float4*)(smem + 4096 + (k * 2 + 1) * 256 + lane * 4);
        h[0] = p4.x * h[0] + h4.x; h[1] = p4.y * h[1] + h4.y; h[2] = p4.z * h[2] + h4.z; h[3] = p4.w * h[3] + h4.w;
    }
#pragma unroll
    for (int i = 0; i < 16; ++i) {
        float o[4];
        const float rg[4] = {bflo(rgv[i].x), bfhi(rgv[i].x), bflo(rgv[i].y), bfhi(rgv[i].y)};
#pragma unroll
        for (int j = 0; j < 4; ++j) {
            const unsigned q = lau[i][j];
                const h2x_t p = __builtin_bit_cast(h2x_t, q);
            h[j] = __builtin_amdgcn_exp2f((float)p[0]) * h[j] + (float)p[1];
            o[j] = gelu_tanh_f(rg[j]) * h[j];
        }
        u32x2_t ov; ov.x = pack2bf(o[0], o[1]); ov.y = pack2bf(o[2], o[3]);
        *(u32x2_t*)(O + (t0 + i) * DM + 768 + lane * 4) = ov;
    }
    __syncthreads();
}

template <bool F32RES>
__device__ __forceinline__ void phase_ln1(const Params& P, int layer) {
    const float* xin = P.x; const bf16_t* xinb = (const bf16_t*)P.out;
    const bf16_t* X1R = (const bf16_t*)(P.ws + WS_X1R);
    bf16_t* X1B = (bf16_t*)(P.ws + WS_X1B);
    const float* g = P.ln1_g + layer * DM; const float* bt = P.ln1_b + layer * DM;
    const int tid = otid(P.wv), wave = tid >> 6, lane = tid & 63;
    for (int row = blockIdx.x * 8 + wave; row < T; row += gridDim.x * 8) {
        float4 v[4]; float s = 0.f;
#pragma unroll
        for (int j = 0; j < 4; ++j) {
            const size_t idx = (size_t)row * DM + j * 256 + lane * 4;
            float4 a;
            if (F32RES) a = *(const float4*)(xin + idx);
            else { const u32x2_t ab = *(const u32x2_t*)(xinb + idx); a = make_float4(bflo(ab.x), bfhi(ab.x), bflo(ab.y), bfhi(ab.y)); }
            const u32x2_t m = *(const u32x2_t*)(X1R + idx);
            v[j] = make_float4(DN_ALPHA * a.x + bflo(m.x), DN_ALPHA * a.y + bfhi(m.x), DN_ALPHA * a.z + bflo(m.y), DN_ALPHA * a.w + bfhi(m.y));
            s += (v[j].x + v[j].y) + (v[j].z + v[j].w);
        }
        const float mean = wave_sum(s) * (1.f / DM);
        float s2 = 0.f;
#pragma unroll
        for (int j = 0; j < 4; ++j) {
            v[j].x -= mean; v[j].y -= mean; v[j].z -= mean; v[j].w -= mean;
            s2 += (v[j].x * v[j].x + v[j].y * v[j].y) + (v[j].z * v[j].z + v[j].w * v[j].w);
        }
        const float rstd = rsqrtf(wave_sum(s2) * (1.f / DM) + 1e-5f);
#pragma unroll
        for (int j = 0; j < 4; ++j) {
            const int col = j * 256 + lane * 4;
            const float4 gg = *(const float4*)(g + col), bb = *(const float4*)(bt + col);
            u32x2_t w;
            w.x = pack2bf(v[j].x * rstd * gg.x + bb.x, v[j].y * rstd * gg.y + bb.y);
            w.y = pack2bf(v[j].z * rstd * gg.z + bb.z, v[j].w * rstd * gg.w + bb.w);
            *(u32x2_t*)(X1B + (size_t)row * DM + col) = w;
        }
    }
}

#define KEY_INSERT(tv, key) do { float cv_ = (key); \
    _Pragma("unroll") for (int j_ = 0; j_ < 16; ++j_) { const float hi_ = __builtin_fmaxf(tv[j_], cv_); cv_ = __builtin_fminf(tv[j_], cv_); tv[j_] = hi_; } } while (0)

#define CE_(x, y) do { const float h_ = __builtin_fmaxf(x, y); y = __builtin_fminf(x, y); x = h_; } while (0)
#define SORT16(A) do { CE_(A[0], A[13]); CE_(A[1], A[12]); CE_(A[2], A[15]); CE_(A[3], A[14]); CE_(A[4], A[8]); CE_(A[5], A[6]); CE_(A[7], A[11]); CE_(A[9], A[10]); CE_(A[0], A[5]); CE_(A[1], A[7]); CE_(A[2], A[9]); CE_(A[3], A[4]); CE_(A[6], A[13]); CE_(A[8], A[14]); CE_(A[10], A[15]); CE_(A[11], A[12]); CE_(A[0], A[1]); CE_(A[2], A[3]); CE_(A[4], A[5]); CE_(A[6], A[8]); CE_(A[7], A[9]); CE_(A[10], A[11]); CE_(A[12], A[13]); CE_(A[14], A[15]); CE_(A[0], A[2]); CE_(A[1], A[3]); CE_(A[4], A[10]); CE_(A[5], A[11]); CE_(A[6], A[7]); CE_(A[8], A[9]); CE_(A[12], A[14]); CE_(A[13], A[15]); CE_(A[1], A[2]); CE_(A[3], A[12]); CE_(A[4], A[6]); CE_(A[5], A[7]); CE_(A[8], A[10]); CE_(A[9], A[11]); CE_(A[13], A[14]); CE_(A[1], A[4]); CE_(A[2], A[6]); CE_(A[5], A[8]); CE_(A[7], A[10]); CE_(A[9], A[13]); CE_(A[11], A[14]); CE_(A[2], A[4]); CE_(A[3], A[6]); CE_(A[9], A[12]); CE_(A[11], A[13]); CE_(A[3], A[5]); CE_(A[6], A[8]); CE_(A[7], A[9]); CE_(A[10], A[12]); CE_(A[3], A[4]); CE_(A[5], A[6]); CE_(A[7], A[8]); CE_(A[9], A[10]); CE_(A[11], A[12]); CE_(A[6], A[7]); CE_(A[8], A[9]); } while (0)
#define TOP16_MERGE(A, B) do { CE_(A[0], B[15]); CE_(A[1], B[14]); CE_(A[2], B[13]); CE_(A[3], B[12]); CE_(A[4], B[11]); CE_(A[5], B[10]); CE_(A[6], B[9]); CE_(A[7], B[8]); CE_(A[8], B[7]); CE_(A[9], B[6]); CE_(A[10], B[5]); CE_(A[11], B[4]); CE_(A[12], B[3]); CE_(A[13], B[2]); CE_(A[14], B[1]); CE_(A[15], B[0]); CE_(A[0], A[8]); CE_(A[1], A[9]); CE_(A[2], A[10]); CE_(A[3], A[11]); CE_(A[4], A[12]); CE_(A[5], A[13]); CE_(A[6], A[14]); CE_(A[7], A[15]); CE_(A[0], A[4]); CE_(A[1], A[5]); CE_(A[2], A[6]); CE_(A[3], A[7]); CE_(A[8], A[12]); CE_(A[9], A[13]); CE_(A[10], A[14]); CE_(A[11], A[15]); CE_(A[0], A[2]); CE_(A[1], A[3]); CE_(A[4], A[6]); CE_(A[5], A[7]); CE_(A[8], A[10]); CE_(A[9], A[11]); CE_(A[12], A[14]); CE_(A[13], A[15]); CE_(A[0], A[1]); CE_(A[2], A[3]); CE_(A[4], A[5]); CE_(A[6], A[7]); CE_(A[8], A[9]); CE_(A[10], A[11]); CE_(A[12], A[13]); CE_(A[14], A[15]); } while (0)

constexpr int TK_SC = 17408;
constexpr int TK_LST = TK_SC;
constexpr int TK_ITL = TK_SC + 2 * 4 * 128 * 20;
template <bool OWN>
__device__ __forceinline__ void phase_topk(const Params& P, int layer, float* smem) {
    const bf16_t* Q = (const bf16_t*)(P.ws + WS_Q);
    int* EXP = (int*)(P.ws + WS_EXP);
    float* GAT = (float*)(P.ws + WS_GAT);
    const int tid = otid(P.wv), lane = tid & 63, w = tid >> 6, r16 = lane & 15, g = lane >> 4, row = tid & 127, qtr = tid >> 7;
    bf16_t* kl = (bf16_t*)smem;
    float* LST = smem + TK_LST;
    int* itl = (int*)(smem + TK_ITL);
    {
        if (tid < 64) {
            int key = -1;
            if (OWN) { pg8::StaticOrder S; S.init(T, 3072, (int)gridDim.x, (int)blockIdx.x); pg8::Unit un; if (S.next(tid, un) && un.pn < 8) key = (un.pn << 16) | un.pm; }
            else { const int item = (int)blockIdx.x + tid * (int)gridDim.x; if (item < 1024) key = ((item & 7) << 16) | (item >> 3); }
            itl[tid] = key;
        }
        __syncthreads();
        if (tid < 64) {
            const int key = itl[tid]; int rank = 0, cnt = 0;
            for (int e = 0; e < 64; ++e) { const int ke = itl[e]; if (ke >= 0) { ++cnt; if (ke < key) ++rank; } }
            if (key >= 0) itl[64 + rank] = key;
            if (tid == 0) itl[128] = cnt;
        }
        __syncthreads();
    }
    const int nit = itl[128];
    const int nu = 2 * nit;
    if (nu <= 0) return;
    const size_t qoff = (size_t)(16 * w + r16) * 2048 + 8 * g;
    const unsigned g4 = 4u * (unsigned)g;
    const bool godd = (g & 1) != 0;
    bf16x8_t aq[2][4];
    {
        const int key = itl[64], h = key >> 16;
        const size_t tok0 = (size_t)(key & 0xffff) * 256;
#pragma unroll
        for (int c = 0; c < 2; ++c)
#pragma unroll
            for (int ks = 0; ks < 4; ++ks) aq[c][ks] = *(const bf16x8_t*)(Q + tok0 * 2048 + qoff + h * 256 + c * 128 + 32 * ks);
    }
    int hcur = -1;
#pragma unroll 1
    for (int u = 0; u < nu; ++u) {
        const int k = u >> 1, key = itl[64 + k], h = key >> 16, tile = key & 0xffff, st = u & 1;
        if (h != hcur) {
            const u32x4_t* src = (const u32x4_t*)((const bf16_t*)(P.ws + WS_SKB) + ((size_t)layer * 8 + h) * 32768);
            for (int i = tid; i < 4096; i += NTH) { const u32x4_t v = src[i]; *(u32x4_t*)(kl + (i >> 4) * 136 + (i & 15) * 8) = v; }
            __syncthreads();
            hcur = h;
        }
        float L0[16], L1[16];
#pragma unroll
        for (int c = 0; c < 2; ++c) {
            f32x4_t acc[8];
#pragma unroll
            for (int nt = 0; nt < 8; ++nt) acc[nt] = (f32x4_t){0.f, 0.f, 0.f, 0.f};
#pragma unroll
            for (int ks = 0; ks < 4; ++ks)
#pragma unroll
                for (int nt = 0; nt < 8; ++nt) {
                    const bf16x8_t kfr = *(const bf16x8_t*)(kl + (c * 128 + 16 * nt + r16) * 136 + 32 * ks + 8 * g);
                    acc[nt] = __builtin_amdgcn_mfma_f32_16x16x32_bf16(kfr, aq[c][ks], acc[nt], 0, 0, 0);
                }
            if (c == 1 && u + 1 < nu) {
                const int nkey = itl[64 + ((u + 1) >> 1)], nh = nkey >> 16;
                const size_t ntok0 = (size_t)(nkey & 0xffff) * 256 + ((u + 1) & 1) * 128;
#pragma unroll
                for (int c2 = 0; c2 < 2; ++c2)
#pragma unroll
                    for (int ks = 0; ks < 4; ++ks) aq[c2][ks] = *(const bf16x8_t*)(Q + ntok0 * 2048 + qoff + nh * 256 + c2 * 128 + 32 * ks);
            }
            float x[32];
#pragma unroll
            for (int nt = 0; nt < 8; ++nt)
#pragma unroll
                for (int rg = 0; rg < 4; ++rg) x[nt * 4 + rg] = __uint_as_float(((__float_as_uint(acc[nt][rg]) & ~127u) | g4) | (unsigned)(16 * nt + rg));
            SORT16(x); SORT16((x + 16)); TOP16_MERGE(x, (x + 16));
#pragma unroll
            for (int j = 0; j < 16; ++j) { if (c == 0) L0[j] = x[j]; else L1[j] = x[j]; }
        }
        float M[16], R[16];
#pragma unroll
        for (int j = 0; j < 16; ++j) { const float snd = godd ? L0[j] : L1[j]; R[j] = __shfl_xor(snd, 16); M[j] = godd ? L1[j] : L0[j]; }
        TOP16_MERGE(M, R);
#pragma unroll
        for (int j = 0; j < 16; ++j) R[j] = __shfl_xor(M[j], 32);
        TOP16_MERGE(M, R);
        float* lst = LST + (k & 1) * (4 * 128 * 20);
        if (g < 2) {
            float* pd = lst + ((st * 2 + g) * 128 + 16 * w + r16) * 20;
#pragma unroll
            for (int j4 = 0; j4 < 4; ++j4) *(float4*)(pd + j4 * 4) = make_float4(M[j4 * 4], M[j4 * 4 + 1], M[j4 * 4 + 2], M[j4 * 4 + 3]);
        }
        if (st == 1) {
            __syncthreads();
            if (tid < 256) {
                const float* x0 = lst + ((qtr * 2 + 0) * 128 + row) * 20;
                const float* x1 = lst + ((qtr * 2 + 1) * 128 + row) * 20;
#pragma unroll
                for (int j4 = 0; j4 < 4; ++j4) {
                    const float4 va = *(const float4*)(x0 + j4 * 4), vb = *(const float4*)(x1 + j4 * 4);
                    L0[j4 * 4] = va.x; L0[j4 * 4 + 1] = va.y; L0[j4 * 4 + 2] = va.z; L0[j4 * 4 + 3] = va.w;
                    L1[j4 * 4] = vb.x; L1[j4 * 4 + 1] = vb.y; L1[j4 * 4 + 2] = vb.z; L1[j4 * 4 + 3] = vb.w;
                }
                float s1[16];
#pragma unroll
                for (int j = 0; j < 16; ++j) s1[j] = __uint_as_float(__float_as_uint(L1[j]) & ~127u);
#define CKEY_(a2, bb) __uint_as_float((__float_as_uint(__uint_as_float(__float_as_uint(L0[a2]) & ~127u) + s1[bb]) & ~255u) | (unsigned)((a2) * 16 + (bb)))
                float bv[16], c1[16], c2[16], c3[16];
#pragma unroll
                for (int j = 0; j < 16; ++j) { bv[j] = CKEY_(0, j); c1[j] = (j < 8) ? CKEY_(1, j) : -INFINITY; }
                c2[0] = CKEY_(2, 0); c2[1] = CKEY_(2, 1); c2[2] = CKEY_(2, 2); c2[3] = CKEY_(2, 3); c2[4] = CKEY_(2, 4);
                c2[5] = CKEY_(3, 0); c2[6] = CKEY_(3, 1); c2[7] = CKEY_(3, 2); c2[8] = CKEY_(3, 3);
                c2[9] = CKEY_(4, 0); c2[10] = CKEY_(4, 1); c2[11] = CKEY_(4, 2);
                c2[12] = -INFINITY; c2[13] = -INFINITY; c2[14] = -INFINITY; c2[15] = -INFINITY;
                c3[0] = CKEY_(5, 0); c3[1] = CKEY_(5, 1); c3[2] = CKEY_(6, 0); c3[3] = CKEY_(6, 1); c3[4] = CKEY_(7, 0); c3[5] = CKEY_(7, 1);
                c3[6] = CKEY_(8, 0); c3[7] = CKEY_(9, 0); c3[8] = CKEY_(10, 0); c3[9] = CKEY_(11, 0); c3[10] = CKEY_(12, 0); c3[11] = CKEY_(13, 0); c3[12] = CKEY_(14, 0); c3[13] = CKEY_(15, 0);
                c3[14] = -INFINITY; c3[15] = -INFINITY;
#undef CKEY_
                TOP16_MERGE(bv, c1);
                SORT16(c2); TOP16_MERGE(bv, c2);
                SORT16(c3); TOP16_MERGE(bv, c3);
                float lg[16]; int ex[16];
#pragma unroll
                for (int j = 0; j < 16; ++j) {
                    const unsigned pr = __float_as_uint(bv[j]) & 255u;
                    const unsigned k0 = __float_as_uint(x0[pr >> 4]), k1 = __float_as_uint(x1[pr & 15]);
                    lg[j] = __uint_as_float(k0 & ~127u) + __uint_as_float(k1 & ~127u);
                    ex[j] = (int)((k0 & 127u) * 128u + (k1 & 127u));
                }
                float mx = lg[0];
#pragma unroll
                for (int j = 1; j < 16; ++j) mx = fmaxf(mx, lg[j]);
                float e[16], sum = 0.f;
#pragma unroll
                for (int j = 0; j < 16; ++j) { e[j] = fast_exp(lg[j] - mx); sum += e[j]; }
                const float inv = 1.f / sum;
                const size_t t = (size_t)tile * 256 + qtr * 128 + row;
                int4* eo = (int4*)(EXP + t * 128 + h * 16);
                float4* go = (float4*)(GAT + t * 128 + h * 16);
#pragma unroll
                for (int j4 = 0; j4 < 4; ++j4) {
                    eo[j4] = make_int4(ex[j4 * 4], ex[j4 * 4 + 1], ex[j4 * 4 + 2], ex[j4 * 4 + 3]);
                    go[j4] = make_float4(e[j4 * 4] * inv, e[j4 * 4 + 1] * inv, e[j4 * 4 + 2] * inv, e[j4 * 4 + 3] * inv);
                }
            }
        }
    }
    __syncthreads();
}

typedef float f32x2_t __attribute__((ext_vector_type(2)));
#define FP8_UNPACK16(q, f) do { f32x2_t p_; \
    p_ = __builtin_amdgcn_cvt_pk_f32_fp8((int)(q).x, false); f[0] = p_.x; f[1] = p_.y; p_ = __builtin_amdgcn_cvt_pk_f32_fp8((int)(q).x, true); f[2] = p_.x; f[3] = p_.y; \
    p_ = __builtin_amdgcn_cvt_pk_f32_fp8((int)(q).y, false); f[4] = p_.x; f[5] = p_.y; p_ = __builtin_amdgcn_cvt_pk_f32_fp8((int)(q).y, true); f[6] = p_.x; f[7] = p_.y; \
    p_ = __builtin_amdgcn_cvt_pk_f32_fp8((int)(q).z, false); f[8] = p_.x; f[9] = p_.y; p_ = __builtin_amdgcn_cvt_pk_f32_fp8((int)(q).z, true); f[10] = p_.x; f[11] = p_.y; \
    p_ = __builtin_amdgcn_cvt_pk_f32_fp8((int)(q).w, false); f[12] = p_.x; f[13] = p_.y; p_ = __builtin_amdgcn_cvt_pk_f32_fp8((int)(q).w, true); f[14] = p_.x; f[15] = p_.y; } while (0)
__device__ __forceinline__ void phase_peer_eval(const Params& P, int layer) {
    const bf16_t* X1B = (const bf16_t*)(P.ws + WS_X1B);
    const bf16_t* E = (const bf16_t*)(P.ws + WS_PE);
    const int* EXP = (const int*)(P.ws + WS_EXP);
    const float* GAT = (const float*)(P.ws + WS_GAT);
    const unsigned char* UB = (const unsigned char*)(P.ws + WS_UB);
    const unsigned char* VB = (const unsigned char*)(P.ws + WS_VB);
    bf16_t* XB = (bf16_t*)(P.ws + WS_XB);
    float* OUT = P.out;
    const float* g = P.ln2_g + layer * DM; const float* bt = P.ln2_b + layer * DM;
    const int tid = otid(P.wv), wave = tid >> 6, lane = tid & 63;
    const bool hi32 = (lane & 32) != 0, b16 = (lane & 16) != 0, b8 = (lane & 8) != 0;
    const int kk = 4 * (lane >> 5) + 2 * ((lane >> 4) & 1) + ((lane >> 3) & 1);
    for (int tok = blockIdx.x * 8 + wave; tok < T; tok += gridDim.x * 8) {
        float xv[16], yv[16];
#pragma unroll
        for (int j = 0; j < 2; ++j) {
            const u32x4_t w = *(const u32x4_t*)(X1B + (size_t)tok * DM + lane * 16 + j * 8);
            xv[j * 8 + 0] = bflo(w.x); xv[j * 8 + 1] = bfhi(w.x); xv[j * 8 + 2] = bflo(w.y); xv[j * 8 + 3] = bfhi(w.y);
            xv[j * 8 + 4] = bflo(w.z); xv[j * 8 + 5] = bfhi(w.z); xv[j * 8 + 6] = bflo(w.w); xv[j * 8 + 7] = bfhi(w.w);
        }
#pragma unroll
        for (int i = 0; i < 16; ++i) yv[i] = 0.f;
        const int e_lo = EXP[(size_t)tok * 128 + lane], e_hi = EXP[(size_t)tok * 128 + 64 + lane];
        const float g_lo = GAT[(size_t)tok * 128 + lane], g_hi = GAT[(size_t)tok * 128 + 64 + lane];
#pragma unroll 2
        for (int gi = 0; gi < 16; ++gi) {
            const int esel = (gi < 8) ? e_lo : e_hi;
            const float gsel = (gi < 8) ? g_lo : g_hi;
            const int l0 = (gi & 7) * 8;
            u32x4_t uq[8], vq[8];
#pragma unroll
            for (int k = 0; k < 8; ++k) {
                const int ex = __builtin_amdgcn_readlane(esel, l0 + k);
                uq[k] = *(const u32x4_t*)(UB + (size_t)ex * DM + lane * 16);
                vq[k] = *(const u32x4_t*)(VB + (size_t)ex * DM + lane * 16);
            }
            float d[8];
#pragma unroll
            for (int k = 0; k < 8; ++k) {
                float f[16]; FP8_UNPACK16(uq[k], f);
                float acc = 0.f;
#pragma unroll
                for (int i = 0; i < 16; ++i) acc += f[i] * xv[i];
                d[k] = acc;
            }
            float r4[4], r2[2];
#pragma unroll
            for (int k = 0; k < 4; ++k) { const float send = hi32 ? d[k] : d[k + 4]; const float keep = hi32 ? d[k + 4] : d[k]; r4[k] = keep + __shfl_xor(send, 32); }
#pragma unroll
            for (int k = 0; k < 2; ++k) { const float send = b16 ? r4[k] : r4[k + 2]; const float keep = b16 ? r4[k + 2] : r4[k]; r2[k] = keep + __shfl_xor(send, 16); }
            float tsum;
            { const float send = b8 ? r2[0] : r2[1]; const float keep = b8 ? r2[1] : r2[0]; tsum = keep + __shfl_xor(send, 8); }
            tsum += __shfl_xor(tsum, 4); tsum += __shfl_xor(tsum, 2); tsum += __shfl_xor(tsum, 1);
            const float gt = __shfl(gsel, l0 + kk);
            const float hvl = gelu_tanh_f(tsum * (1.f / FP8_SU)) * gt * (1.f / FP8_SV);
#pragma unroll
            for (int k = 0; k < 8; ++k) {
                const float hv = __uint_as_float((unsigned)__builtin_amdgcn_readlane((int)__float_as_uint(hvl), 32 * (k >> 2) + 16 * ((k >> 1) & 1) + 8 * (k & 1)));
                float f[16]; FP8_UNPACK16(vq[k], f);
#pragma unroll
                for (int i = 0; i < 16; ++i) yv[i] += hv * f[i];
            }
        }
        float s = 0.f;
#pragma unroll
        for (int j = 0; j < 2; ++j) {
            const u32x4_t w = *(const u32x4_t*)(E + (size_t)tok * DM + lane * 16 + j * 8);
            const float ev[8] = {bflo(w.x), bfhi(w.x), bflo(w.y), bfhi(w.y), bflo(w.z), bfhi(w.z), bflo(w.w), bfhi(w.w)};
#pragma unroll
            for (int i = 0; i < 8; ++i) { yv[j * 8 + i] = DN_ALPHA * xv[j * 8 + i] + yv[j * 8 + i] + ev[i]; s += yv[j * 8 + i]; }
        }
        const float mean = wave_sum(s) * (1.f / DM);
        float s2 = 0.f;
#pragma unroll
        for (int i = 0; i < 16; ++i) { yv[i] -= mean; s2 += yv[i] * yv[i]; }
        const float rstd = rsqrtf(wave_sum(s2) * (1.f / DM) + 1e-5f);
        float ov[16];
#pragma unroll
        for (int j = 0; j < 4; ++j) {
            const int col = lane * 16 + j * 4;
            const float4 gg = *(const float4*)(g + col), bb = *(const float4*)(bt + col);
            ov[j * 4 + 0] = yv[j * 4 + 0] * rstd * gg.x + bb.x; ov[j * 4 + 1] = yv[j * 4 + 1] * rstd * gg.y + bb.y;
            ov[j * 4 + 2] = yv[j * 4 + 2] * rstd * gg.z + bb.z; ov[j * 4 + 3] = yv[j * 4 + 3] * rstd * gg.w + bb.w;
            *(float4*)(OUT + (size_t)tok * DM + col) = make_float4(ov[j * 4 + 0], ov[j * 4 + 1], ov[j * 4 + 2], ov[j * 4 + 3]);
        }
#pragma unroll
        for (int j = 0; j < 2; ++j) {
            u32x4_t w; w.x = pack2bf(ov[j * 8 + 0], ov[j * 8 + 1]); w.y = pack2bf(ov[j * 8 + 2], ov[j * 8 + 3]); w.z = pack2bf(ov[j * 8 + 4], ov[j * 8 + 5]); w.w = pack2bf(ov[j * 8 + 6], ov[j * 8 + 7]);
            *(u32x4_t*)(XB + (size_t)tok * DM + lane * 16 + j * 8) = w;
        }
    }
}

constexpr float FP4_SU = 64.f, FP4_SV = 4.f;
__device__ __forceinline__ void convert_fp4(const float* __restrict__ src, unsigned char* __restrict__ dst, size_t n, float scale, int gtid, int gnth) {
    size_t i = (size_t)gtid * 32;
    if (i >= n) return;
    f32x4_t r0, r1, r2, r3, r4, r5, r6, r7;
#define CV_LD_(p) do { r0 = *(const f32x4_t*)(p); r1 = *(const f32x4_t*)((p) + 4); r2 = *(const f32x4_t*)((p) + 8); r3 = *(const f32x4_t*)((p) + 12); \
                       r4 = *(const f32x4_t*)((p) + 16); r5 = *(const f32x4_t*)((p) + 20); r6 = *(const f32x4_t*)((p) + 24); r7 = *(const f32x4_t*)((p) + 28); } while (0)
#define CV_PK_(a, b) ({ unsigned v_ = 0; \
        v_ = __builtin_amdgcn_cvt_scalef32_pk_fp4_f32(v_, (a)[0] * scale, (a)[1] * scale, 1.0f, 0); v_ = __builtin_amdgcn_cvt_scalef32_pk_fp4_f32(v_, (a)[2] * scale, (a)[3] * scale, 1.0f, 1); \
        v_ = __builtin_amdgcn_cvt_scalef32_pk_fp4_f32(v_, (b)[0] * scale, (b)[1] * scale, 1.0f, 2); v_ = __builtin_amdgcn_cvt_scalef32_pk_fp4_f32(v_, (b)[2] * scale, (b)[3] * scale, 1.0f, 3); v_; })
    CV_LD_(src + i);
    for (;;) {
        const size_t in = i + (size_t)gnth * 32;
        const bool more = in < n;
        u32x4_t w;
        w.x = CV_PK_(r0, r1); w.y = CV_PK_(r2, r3); w.z = CV_PK_(r4, r5); w.w = CV_PK_(r6, r7);
        const float* spn = src + (more ? in : i);
        CV_LD_(spn);
        *(u32x4_t*)(dst + (i >> 1)) = w;
        if (!more) break;
        i = in;
    }
#undef CV_LD_
#undef CV_PK_
}
__device__ __forceinline__ void convert_fp4_perm(const float* __restrict__ src, unsigned char* __restrict__ dst, size_t n, float scale, const unsigned char* __restrict__ PI, float* smem, int wv) {
    const int tid = otid(wv), wave = tid >> 6, lane = tid & 63, wi = lane >> 2, q = lane & 3;
    float* wl = smem + wave * (16 * 132);
    unsigned off[32];
    {
        const u32x4_t p0 = *(const u32x4_t*)(PI + 32 * q), p1 = *(const u32x4_t*)(PI + 32 * q + 16);
        const unsigned pw[8] = {p0.x, p0.y, p0.z, p0.w, p1.x, p1.y, p1.z, p1.w};
#pragma unroll
        for (int j = 0; j < 32; ++j) off[j] = (unsigned)wi * 132u + ((pw[j >> 2] >> (8 * (j & 3))) & 255u);
    }
    const int nchunks = (int)(n >> 11);
    int c = blockIdx.x * 8 + wave;
    if (c >= nchunks) return;
    f32x4_t r0, r1, r2, r3, r4, r5, r6, r7;
#define CU_LD_(p) do { r0 = *(const f32x4_t*)((p) + lane * 4); r1 = *(const f32x4_t*)((p) + 256 + lane * 4); r2 = *(const f32x4_t*)((p) + 512 + lane * 4); r3 = *(const f32x4_t*)((p) + 768 + lane * 4); \
                       r4 = *(const f32x4_t*)((p) + 1024 + lane * 4); r5 = *(const f32x4_t*)((p) + 1280 + lane * 4); r6 = *(const f32x4_t*)((p) + 1536 + lane * 4); r7 = *(const f32x4_t*)((p) + 1792 + lane * 4); } while (0)
#define CU_ST_(i_, r_) do { const int p_ = ((i_) * 64 + lane) * 4; *(f32x4_t*)(wl + (p_ >> 7) * 132 + (p_ & 127)) = r_; } while (0)
    CU_LD_(src + (size_t)c * 2048);
    for (;; ) {
        CU_ST_(0, r0); CU_ST_(1, r1); CU_ST_(2, r2); CU_ST_(3, r3); CU_ST_(4, r4); CU_ST_(5, r5); CU_ST_(6, r6); CU_ST_(7, r7);
        const int cn = c + gridDim.x * 8;
        const bool more = cn < nchunks;
        const float* spn = src + (size_t)(more ? cn : c) * 2048;
        CU_LD_(spn);
        u32x4_t w;
#pragma unroll
        for (int j = 0; j < 4; ++j) {
            float f[8];
#pragma unroll
            for (int e = 0; e < 8; ++e) f[e] = wl[off[j * 8 + e]] * scale;
            unsigned v = 0;
            v = __builtin_amdgcn_cvt_scalef32_pk_fp4_f32(v, f[0], f[1], 1.0f, 0);
            v = __builtin_amdgcn_cvt_scalef32_pk_fp4_f32(v, f[2], f[3], 1.0f, 1);
            v = __builtin_amdgcn_cvt_scalef32_pk_fp4_f32(v, f[4], f[5], 1.0f, 2);
            v = __builtin_amdgcn_cvt_scalef32_pk_fp4_f32(v, f[6], f[7], 1.0f, 3);
            w[j] = v;
        }
        *(u32x4_t*)(dst + (size_t)c * 1024 + lane * 16) = w;
        if (!more) break;
        c = cn;
    }
#undef CU_LD_
#undef CU_ST_
}
#define FP4_UNPACK16(q, f) do { f32x2_t p_; \
    p_ = __builtin_amdgcn_cvt_scalef32_pk_f32_fp4((q).x, 1.0f, 0); f[0] = p_.x; f[1] = p_.y; p_ = __builtin_amdgcn_cvt_scalef32_pk_f32_fp4((q).x, 1.0f, 1); f[2] = p_.x; f[3] = p_.y; \
    p_ = __builtin_amdgcn_cvt_scalef32_pk_f32_fp4((q).x, 1.0f, 2); f[4] = p_.x; f[5] = p_.y; p_ = __builtin_amdgcn_cvt_scalef32_pk_f32_fp4((q).x, 1.0f, 3); f[6] = p_.x; f[7] = p_.y; \
    p_ = __builtin_amdgcn_cvt_scalef32_pk_f32_fp4((q).y, 1.0f, 0); f[8] = p_.x; f[9] = p_.y; p_ = __builtin_amdgcn_cvt_scalef32_pk_f32_fp4((q).y, 1.0f, 1); f[10] = p_.x; f[11] = p_.y; \
    p_ = __builtin_amdgcn_cvt_scalef32_pk_f32_fp4((q).y, 1.0f, 2); f[12] = p_.x; f[13] = p_.y; p_ = __builtin_amdgcn_cvt_scalef32_pk_f32_fp4((q).y, 1.0f, 3); f[14] = p_.x; f[15] = p_.y; } while (0)
typedef __attribute__((address_space(3))) unsigned lds_u32_t;
typedef _Float16 h2_t __attribute__((ext_vector_type(2)));
constexpr int EVW = 4416;
#define EV_DMA(ESEL, gsub) do { const int l0_ = (gsub) * 16; \
    _Pragma("unroll") for (int k = 0; k < 8; ++k) { \
        const int ea_ = __builtin_amdgcn_readlane(ESEL, l0_ + 2 * k), eb_ = __builtin_amdgcn_readlane(ESEL, l0_ + 2 * k + 1); \
        const unsigned off_ = (unsigned)(hi32 ? eb_ : ea_) * 512u + (unsigned)(lane & 31) * 16u; \
        __builtin_amdgcn_global_load_lds((const unsigned*)(UB + off_), (lds_u32_t*)(wl + k * 1056), 16, 0, 0); \
        __builtin_amdgcn_global_load_lds((const unsigned*)(VB + off_), (lds_u32_t*)(wl + 8448 + k * 1024), 16, 0, 0); } } while (0)
template <bool LASTL>
__device__ __forceinline__ void phase_peer_eval_fp4(const Params& P, int layer, float* smem) {
    const bf16_t* X1B = (const bf16_t*)(P.ws + WS_X1B);
    const bf16_t* E = (const bf16_t*)(P.ws + WS_PE);
    const int* EXP = (const int*)(P.ws + WS_EXP);
    const float* GAT = (const float*)(P.ws + WS_GAT);
    const unsigned char* UB = (const unsigned char*)(P.ws + WS_UB);
    const unsigned char* VB = (const unsigned char*)(P.ws + WS_VB);
    bf16_t* XB = (bf16_t*)P.out;
    float* OUT = P.out;
    const int tid = otid(P.wv), wave = __builtin_amdgcn_readfirstlane(tid >> 6), lane = tid & 63;
    {
        const float* g = P.ln2_g + layer * DM; const float* bt = P.ln2_b + layer * DM;
        for (int i = tid; i < DM; i += NTH) { smem[i] = g[i]; smem[DM + i] = bt[i]; }
        __syncthreads();
    }
    const float* gl = smem + lane * 16;
    char* wl = (char*)(smem + 2 * DM + wave * EVW);
    const unsigned lo16 = (unsigned)lane * 32u, lo8 = (unsigned)lane * 8u;
    const bool hi32 = (lane & 32) != 0;
    const int r16 = lane & 15, kb = lane >> 4;
    const char* ua = wl + (r16 >> 1) * 1056 + (r16 & 1) * 512 + kb * 16;
    const char* xb8 = wl + 16640 + kb * 32;
    const bool xswap = ((unsigned)__builtin_amdgcn_cvt_pk_fp8_f32(1.0f, 2.0f, 0, false) & 0xFFu) != 0x38u;
    const int tstride = gridDim.x * 8;
    int tok = blockIdx.x * 8 + wave;
    if (tok < T) {
    int e_lo, e_hi; float g_lo, g_hi; u32x4_t xp0, xp1;
    {
        const char* idrow = (const char*)uniform_ptr(EXP + (size_t)tok * 128);
        const char* gtrow = (const char*)uniform_ptr(GAT + (size_t)tok * 128);
        const char* xrow = (const char*)uniform_ptr(X1B + (size_t)tok * DM);
        e_lo = *(const int*)(idrow + lane * 4u); e_hi = *(const int*)(idrow + 256 + lane * 4u);
        g_lo = *(const float*)(gtrow + lane * 4u); g_hi = *(const float*)(gtrow + 256 + lane * 4u);
        xp0 = *(const u32x4_t*)(xrow + lo16); xp1 = *(const u32x4_t*)(xrow + lo16 + 16);
    }
    EV_DMA(e_lo, 0);
#pragma unroll 1
    for (; tok < T; tok += tstride) {
        const int ntok = tok + tstride;
        const bool more = ntok < T;
        float yv[16];
        float xf[16];
        {
            const unsigned xw[8] = {xp0.x, xp0.y, xp0.z, xp0.w, xp1.x, xp1.y, xp1.z, xp1.w};
#pragma unroll
            for (int i = 0; i < 8; ++i) { xf[2 * i] = bflo(xw[i]); xf[2 * i + 1] = bfhi(xw[i]); }
            u32x4_t x8;
#pragma unroll
            for (int q = 0; q < 4; ++q) {
                const float a0 = xswap ? xf[4 * q + 1] : xf[4 * q], a1 = xswap ? xf[4 * q] : xf[4 * q + 1];
                const float a2 = xswap ? xf[4 * q + 3] : xf[4 * q + 2], a3 = xswap ? xf[4 * q + 2] : xf[4 * q + 3];
                int v = 0;
                v = __builtin_amdgcn_cvt_pk_fp8_f32(a0, a1, v, false);
                v = __builtin_amdgcn_cvt_pk_fp8_f32(a2, a3, v, true);
                x8[q] = (unsigned)v;
            }
            *(u32x4_t*)(wl + 16640 + lane * 16) = x8;
        }
#pragma unroll
        for (int i = 0; i < 16; ++i) yv[i] = 0.f;
        int ne_lo = 0, ne_hi = 0; float ng_lo = 0.f, ng_hi = 0.f;
        if (more) {
            const char* idrow = (const char*)uniform_ptr(EXP + (size_t)ntok * 128);
            const char* gtrow = (const char*)uniform_ptr(GAT + (size_t)ntok * 128);
            const char* xrow = (const char*)uniform_ptr(X1B + (size_t)ntok * DM);
            ne_lo = *(const int*)(idrow + lane * 4u); ne_hi = *(const int*)(idrow + 256 + lane * 4u);
            ng_lo = *(const float*)(gtrow + lane * 4u); ng_hi = *(const float*)(gtrow + 256 + lane * 4u);
            xp0 = *(const u32x4_t*)(xrow + lo16); xp1 = *(const u32x4_t*)(xrow + lo16 + 16);
        }
#pragma unroll 1
        for (int gi = 0; gi < 8; ++gi) {
            const float gsel = (gi < 4) ? g_lo : g_hi;
            const int l0 = (gi & 3) * 16;
            asm volatile("s_waitcnt vmcnt(0)" ::: "memory");
            u32x2_t vq[16];
#pragma unroll
            for (int k = 0; k < 16; ++k) vq[k] = *(const u32x2_t*)(wl + 8448 + k * 512 + lo8);
            u32x4_t af[8];
#pragma unroll
            for (int ks = 0; ks < 8; ++ks) af[ks] = *(const u32x4_t*)(ua + ks * 64);
            asm volatile("s_waitcnt lgkmcnt(0)" ::: "memory");
            if (gi < 3) { EV_DMA(e_lo, gi + 1); } else if (gi < 7) { EV_DMA(e_hi, gi - 3); } else if (more) { EV_DMA(ne_lo, 0); }
            f32x4_t dacc = (f32x4_t){0.f, 0.f, 0.f, 0.f};
#pragma unroll
            for (int ks = 0; ks < 8; ++ks) {
                const u32x4_t b0 = *(const u32x4_t*)(xb8 + ks * 128), b1 = *(const u32x4_t*)(xb8 + ks * 128 + 16);
                const v8i_t av = {(int)af[ks].x, (int)af[ks].y, (int)af[ks].z, (int)af[ks].w, 0, 0, 0, 0};
                const v8i_t bv = {(int)b0.x, (int)b0.y, (int)b0.z, (int)b0.w, (int)b1.x, (int)b1.y, (int)b1.z, (int)b1.w};
                dacc = __builtin_amdgcn_mfma_scale_f32_16x16x128_f8f6f4(av, bv, dacc, 4, 0, 0, 0x7F7F7F7F, 0, 0x7F7F7F7F);
            }
            float hv4[4];
#pragma unroll
            for (int rg = 0; rg < 4; ++rg) {
                const float gt = __shfl(gsel, l0 + 4 * kb + rg);
                hv4[rg] = gelu_tanh_f(dacc[rg] * (1.f / FP4_SU)) * gt * (1.f / FP4_SV);
            }
#pragma unroll
            for (int k = 0; k < 16; ++k) {
                const float hv = __uint_as_float((unsigned)__builtin_amdgcn_readlane((int)__float_as_uint(hv4[k & 3]), 16 * (k >> 2)));
                float f[16]; FP4_UNPACK16(vq[k], f);
#pragma unroll
                for (int i = 0; i < 16; ++i) yv[i] += hv * f[i];
            }
        }
        const char* erow = (const char*)uniform_ptr(E + (size_t)tok * DM);
        char* orow = (char*)uniform_ptr(OUT + (size_t)tok * DM);
        char* xbrow = (char*)uniform_ptr(XB + (size_t)tok * DM);
        float s = 0.f;
#pragma unroll
        for (int j = 0; j < 2; ++j) {
            const u32x4_t w = *(const u32x4_t*)(erow + lo16 + j * 16);
            const float ev[8] = {bflo(w.x), bfhi(w.x), bflo(w.y), bfhi(w.y), bflo(w.z), bfhi(w.z), bflo(w.w), bfhi(w.w)};
#pragma unroll
            for (int i = 0; i < 8; ++i) { yv[j * 8 + i] = DN_ALPHA * xf[j * 8 + i] + yv[j * 8 + i] + ev[i]; s += yv[j * 8 + i]; }
        }
        const float mean = wave_sum(s) * (1.f / DM);
        float s2 = 0.f;
#pragma unroll
        for (int i = 0; i < 16; ++i) { yv[i] -= mean; s2 += yv[i] * yv[i]; }
        const float rstd = rsqrtf(wave_sum(s2) * (1.f / DM) + 1e-5f);
        float ov[16];
#pragma unroll
        for (int j = 0; j < 4; ++j) {
            const float4 gg = *(const float4*)(gl + j * 4), bb = *(const float4*)(gl + DM + j * 4);
            ov[j * 4 + 0] = yv[j * 4 + 0] * rstd * gg.x + bb.x; ov[j * 4 + 1] = yv[j * 4 + 1] * rstd * gg.y + bb.y;
            ov[j * 4 + 2] = yv[j * 4 + 2] * rstd * gg.z + bb.z; ov[j * 4 + 3] = yv[j * 4 + 3] * rstd * gg.w + bb.w;
            if (LASTL) *(float4*)(orow + lane * 64u + j * 16) = make_float4(ov[j * 4 + 0], ov[j * 4 + 1], ov[j * 4 + 2], ov[j * 4 + 3]);
        }
        if (!LASTL) {
#pragma unroll
        for (int j = 0; j < 2; ++j) {
            u32x4_t w; w.x = pack2bf(ov[j * 8 + 0], ov[j * 8 + 1]); w.y = pack2bf(ov[j * 8 + 2], ov[j * 8 + 3]); w.z = pack2bf(ov[j * 8 + 4], ov[j * 8 + 5]); w.w = pack2bf(ov[j * 8 + 6], ov[j * 8 + 7]);
            *(u32x4_t*)(xbrow + lo16 + j * 16) = w;
        }
        }
        e_lo = ne_lo; e_hi = ne_hi; g_lo = ng_lo; g_hi = ng_hi;
    }
    }
    asm volatile("s_waitcnt vmcnt(0)" ::: "memory");
}

template <int PH>
__device__ __forceinline__ void run_phase(const Params& P, int layer, float* smem) {
    if constexpr (PH == 0) phase_prologue(P, smem);
    if constexpr (PH == 1) {
        pg8::EpiBf16P E{(bf16_t*)(P.ws + WS_H), HP};
        run_gemm(smem, (const bf16_t*)P.out, (const bf16_t*)(P.ws + WS_WIN) + (size_t)layer * HP * DM, T, HP, DM, E, P.wv);
        for (int it = blockIdx.x; it < T / 128; it += gridDim.x) alow_item(P, layer, it);
        const int tid = otid(P.wv), gtid = blockIdx.x * NTH + tid, gnth = gridDim.x * NTH;
#if PEER_FP4
        __syncthreads();
        convert_fp4_perm(P.peer_u + (size_t)layer * 16384 * DM, (unsigned char*)(P.ws + WS_UB), (size_t)16384 * DM, FP4_SU, (const unsigned char*)(P.ws + WS_PI), smem, P.wv);
        convert_fp4(P.peer_v + (size_t)layer * 16384 * DM, (unsigned char*)(P.ws + WS_VB), (size_t)16384 * DM, FP4_SV, gtid, gnth);
#else
        convert_fp8(P.peer_u + (size_t)layer * 16384 * DM, (unsigned char*)(P.ws + WS_UB), (size_t)16384 * DM, FP8_SU, gtid, gnth);
        convert_fp8(P.peer_v + (size_t)layer * 16384 * DM, (unsigned char*)(P.ws + WS_VB), (size_t)16384 * DM, FP8_SV, gtid, gnth);
#endif
    }
    if constexpr (PH == 2) {
        for (int it = blockIdx.x; it < 1024; it += gridDim.x) {
            if (it < 512) { swa_item(P, layer, smem, it); if (REPEAT_SUB & 1) swa_item(P, layer, smem, it); }
            else if (it < 768) { gla_pre_item(P, layer, smem, it - 512); if (REPEAT_SUB & 2) gla_pre_item(P, layer, smem, it - 512); }
            else { lru1_item(P, layer, smem, it - 768); if (REPEAT_SUB & 4) lru1_item(P, layer, smem, it - 768); }
        }
        const int tid = otid(P.wv), gtid = blockIdx.x * NTH + tid, gnth = gridDim.x * NTH;
        convert_bf16(P.p + (size_t)layer * T * 256, (bf16_t*)(P.ws + WS_PB), (size_t)T * 256, gtid, gnth);
    }
    if constexpr (PH == 3) for (int it = blockIdx.x; it < 512; it += gridDim.x) {
        if (it < 256) { gla_out_item(P, layer, smem, it); if (REPEAT_SUB & 8) gla_out_item(P, layer, smem, it); }
        else { lru2_item(P, layer, smem, it - 256); if (REPEAT_SUB & 16) lru2_item(P, layer, smem, it - 256); }
    }
    if constexpr (PH == 4) {
        pg8::EpiBf16P E1{(bf16_t*)(P.ws + WS_X1R), DM};
        run_gemm(smem, (const bf16_t*)(P.ws + WS_O), (const bf16_t*)(P.ws + WS_WOUT) + (size_t)layer * DM * DM, T, DM, DM, E1, P.wv);
        pg8::EpiBf16P E2{(bf16_t*)(P.ws + WS_PE), DM};
        run_gemm(smem, (const bf16_t*)(P.ws + WS_PB), (const bf16_t*)(P.ws + WS_WPJ) + (size_t)layer * DM * 256, T, DM, 256, E2, P.wv);
    }
        if constexpr (PH == 5) phase_ln1<false>(P, layer);
    if constexpr (PH == 6) {
        pg8::EpiQG E{(bf16_t*)(P.ws + WS_Q), (bf16_t*)(P.ws + WS_PE)};
        run_gemm(smem, (const bf16_t*)(P.ws + WS_X1B), (const bf16_t*)(P.ws + WS_WQG) + (size_t)layer * 3072 * DM, T, 3072, DM, E, P.wv);
#if FUSED
        phase_topk<true>(P, layer, smem);
#endif
    }
    if constexpr (PH == 7) phase_topk<false>(P, layer, smem);
#if PEER_FP4
    if constexpr (PH == 8) { if (layer == 0) phase_peer_eval_fp4<false>(P, layer, smem); else phase_peer_eval_fp4<true>(P, layer, smem); }
#else
    if constexpr (PH == 8) phase_peer_eval(P, layer);
#endif
}
constexpr int NPH = 8;

#define XB_TMO      128
#define XB_XCNT(j)  (256  + 64 * (j))
#define XB_XSUB(j)  (1280 + 64 * (j))
#define XB_XGEN(j)  (2304 + 64 * (j))
#define XB_TOP      3328
#define XB_TOPGEN   3392
#define XCD_BAR_WORDS 3456
#define XB_SPIN_CAP (1u << 22)

__device__ __forceinline__ unsigned xb_ld(unsigned* p)              { return __hip_atomic_load(p, __ATOMIC_RELAXED, __HIP_MEMORY_SCOPE_AGENT); }
__device__ __forceinline__ unsigned xb_add(unsigned* p, unsigned v) { return __hip_atomic_fetch_add(p, v, __ATOMIC_RELAXED, __HIP_MEMORY_SCOPE_AGENT); }
__device__ __forceinline__ unsigned xb_xcc_id() { return (unsigned)__builtin_amdgcn_s_getreg((3 << 11) | 20) & 0xFu; }
#define XB_SPIN(cond, bar) do { unsigned _sp = 0; while (cond) { __builtin_amdgcn_s_sleep(1); \
    if ((++_sp & 255u) == 0u) { if (xb_ld(&(bar)[XB_TMO])) break; if (_sp > XB_SPIN_CAP) { atomicAdd(&(bar)[XB_TMO], 1u); break; } } } } while (0)

struct XcdBarrier {
    unsigned* bar; unsigned x;
    volatile __attribute__((address_space(3))) unsigned* st;
};

__device__ __forceinline__ XcdBarrier xcd_barrier_post(unsigned* bar, volatile __attribute__((address_space(3))) unsigned* st) {
    XcdBarrier b; b.bar = bar; b.x = xb_xcc_id(); b.st = st;
    if (threadIdx.x == 0) (void)xb_add(&bar[XB_XCNT(b.x)], 1u);
    return b;
}
__device__ __forceinline__ void xcd_barrier_complete(unsigned* bar, unsigned x, unsigned& nloc, unsigned& nx) {
    const unsigned G = gridDim.x * gridDim.y * gridDim.z;
    unsigned sum, cnt, mine, sp = 0u;
    for (;;) {
        sum = 0u; cnt = 0u; mine = 0u;
#pragma unroll
        for (unsigned j = 0; j < 16; ++j) { const unsigned c = xb_ld(&bar[XB_XCNT(j)]); sum += c; cnt += (c > 0u) ? 1u : 0u; mine = (j == x) ? c : mine; }
        if (sum == G) break;
        __builtin_amdgcn_s_sleep(1);
        if ((++sp & 255u) == 0u) { if (xb_ld(&bar[XB_TMO])) break; if (sp > XB_SPIN_CAP) { atomicAdd(&bar[XB_TMO], 1u); break; } }
    }
    nloc = mine > 0u ? mine : 1u; nx = cnt > 0u ? cnt : 1u;
}

__device__ __forceinline__ void xcd_barrier(const XcdBarrier& b) {
    asm volatile("s_waitcnt vmcnt(0)" ::: "memory");
    __syncthreads();
    if (threadIdx.x == 0) {
        unsigned* bar = b.bar;
        __builtin_amdgcn_s_waitcnt(0);
        unsigned nloc = b.st[0], nx = b.st[1];
        if (nloc == 0u) { xcd_barrier_complete(bar, b.x, nloc, nx); b.st[0] = nloc; b.st[1] = nx; }
        const unsigned old = xb_add(&bar[XB_XSUB(b.x)], 1u);
        const unsigned gen = old / nloc;
        if (old + 1u == (gen + 1u) * nloc) {
            __builtin_amdgcn_fence(__ATOMIC_RELEASE, "agent");
            asm volatile("s_waitcnt vmcnt(0)" ::: "memory");
            const unsigned og = xb_add(&bar[XB_TOP], 1u);
            const unsigned tg = og / nx;
            if (og + 1u == (tg + 1u) * nx) xb_add(&bar[XB_TOPGEN], 1u);
            else XB_SPIN(xb_ld(&bar[XB_TOPGEN]) == tg, bar);
            __builtin_amdgcn_fence(__ATOMIC_ACQUIRE, "agent");
            xb_add(&bar[XB_XGEN(b.x)], 1u);
            asm volatile("s_waitcnt vmcnt(0)" ::: "memory");
        } else {
            XB_SPIN(xb_ld(&bar[XB_XGEN(b.x)]) == gen, bar);
            __builtin_amdgcn_fence(__ATOMIC_ACQUIRE, "agent");
            asm volatile("s_waitcnt vmcnt(0)" ::: "memory");
        }
    }
    __syncthreads();
}

#if !FUSED
template <int PH>
__global__ void __launch_bounds__(NTH, 2) phase_kernel(Params P, int layer) {
    extern __shared__ __attribute__((aligned(16))) float smem[];
    P.wv = __builtin_amdgcn_readfirstlane((int)(threadIdx.x >> 6));
    run_phase<PH>(P, layer, smem);
}
#else
__device__ __forceinline__ Params load_params(const Params* lp, int wv) {
    Params q; q.wv = wv; q.pad_ = 0;
#define LP_(f) q.f = (decltype(q.f))uniform_ptr((const void*)lp->f)
    LP_(x); LP_(p); LP_(pos); LP_(w_in); LP_(gla_w_a2); LP_(gla_b_a); LP_(gla_norm_w); LP_(swa_sinks); LP_(lru_conv_w); LP_(lru_conv_b); LP_(lru_w_r);
    LP_(lru_b_r); LP_(lru_w_i); LP_(lru_b_i); LP_(lru_lambda); LP_(w_out); LP_(ln1_g); LP_(ln1_b); LP_(peer_w_q); LP_(peer_sub_keys); LP_(peer_u);
    LP_(peer_v); LP_(ple_w_gate); LP_(ple_w_proj); LP_(ln2_g); LP_(ln2_b); LP_(out); LP_(ws);
#undef LP_
    return q;
}
__global__ void __launch_bounds__(NTH, 2) mega_kernel(Params Pk) {
    extern __shared__ __attribute__((aligned(16))) float smem_all[];
    cg::grid_group grid = cg::this_grid();
    Params* lp = (Params*)smem_all;
    float* smem = smem_all + 64;
    const int wv0 = __builtin_amdgcn_readfirstlane((int)(threadIdx.x >> 6));
    volatile __attribute__((address_space(3))) unsigned* bst = (volatile __attribute__((address_space(3))) unsigned*)smem_all + 60;
    if (blockIdx.x == 0) { unsigned* barw = (unsigned*)(Pk.ws + WS_BAR); for (int i = threadIdx.x; i < XCD_BAR_WORDS; i += NTH) barw[i] = 0u; }
    if (threadIdx.x == 0) { *lp = Pk; bst[0] = 0u; bst[1] = 0u; }
    __syncthreads();
    { const Params P = load_params(lp, wv0); run_phase<0>(P, 0, smem); }
    grid.sync();
    (void)xcd_barrier_post((unsigned*)uniform_ptr(lp->ws + WS_BAR), bst);
#define MK_BARRIER() do { XcdBarrier xb; xb.bar = (unsigned*)uniform_ptr(lp->ws + WS_BAR); xb.x = xb_xcc_id(); xb.st = bst; xcd_barrier(xb); } while (0)
#define MK_STEP(PH, LAYER, LAST) do { \
        { const Params P = load_params(lp, wv0); run_phase<PH>(P, LAYER, smem); } \
        if ((REPEAT_MASK >> PH) & 1) { MK_BARRIER(); { const Params P = load_params(lp, wv0); run_phase<PH>(P, LAYER, smem); } } \
        if (!(LAST)) MK_BARRIER(); } while (0)
    MK_STEP(1, 0, false); MK_STEP(2, 0, false); MK_STEP(3, 0, false); MK_STEP(4, 0, false); MK_STEP(5, 0, false); MK_STEP(6, 0, false); MK_STEP(8, 0, false);
    MK_STEP(1, 1, false); MK_STEP(2, 1, false); MK_STEP(3, 1, false); MK_STEP(4, 1, false); MK_STEP(5, 1, false); MK_STEP(6, 1, false); MK_STEP(8, 1, true);
#undef MK_STEP
#undef MK_BARRIER
}
#endif

#if !FUSED
template <int PH>
static void launch_phase(const Params& P, int layer, int grid, hipStream_t stream) {
    static bool attr_set = false;
    if (!attr_set) { (void)hipFuncSetAttribute((const void*)phase_kernel<PH>, hipFuncAttributeMaxDynamicSharedMemorySize, LDS_BYTES); attr_set = true; }
    hipLaunchKernelGGL(phase_kernel<PH>, dim3(grid), dim3(NTH), LDS_BYTES, stream, P, layer);
}
#endif

extern "C" void kernel_launch(void* const* d_in, const int* in_sizes, int n_in, void* d_out, int out_size, void* d_ws, size_t ws_size, hipStream_t stream) {
    static int grid = 0;
    if (grid == 0) {
        if (n_in != 26 || out_size != T * DM || ws_size < WS_END) { fprintf(stderr, "kernel_launch: unexpected shapes (n_in %d out %d ws %zu)\n", n_in, out_size, ws_size); grid = -1; return; }
        int dev = 0, cus = 0, per_cu = 0;
        (void)hipGetDevice(&dev);
        (void)hipDeviceGetAttribute(&cus, hipDeviceAttributeMultiprocessorCount, dev);
#if FUSED
        (void)hipFuncSetAttribute((const void*)mega_kernel, hipFuncAttributeMaxDynamicSharedMemorySize, LDS_BYTES);
        (void)hipOccupancyMaxActiveBlocksPerMultiprocessor(&per_cu, (const void*)mega_kernel, NTH, LDS_BYTES);
#else
        per_cu = 1;
#endif
        if (per_cu < 1 || cus < 1) { fprintf(stderr, "kernel_launch: occupancy query gave %d blocks/CU on %d CUs\n", per_cu, cus); grid = -1; return; }
        grid = cus * per_cu;
    }
    if (grid < 0) return;
    Params P{};
    P.x = (const float*)d_in[0]; P.p = (const float*)d_in[1]; P.pos = (const int*)d_in[2];
    P.w_in = (const float*)d_in[3]; P.gla_w_a2 = (const float*)d_in[4]; P.gla_b_a = (const float*)d_in[5]; P.gla_norm_w = (const float*)d_in[6];
    P.swa_sinks = (const float*)d_in[7]; P.lru_conv_w = (const float*)d_in[8]; P.lru_conv_b = (const float*)d_in[9]; P.lru_w_r = (const float*)d_in[10];
    P.lru_b_r = (const float*)d_in[11]; P.lru_w_i = (const float*)d_in[12]; P.lru_b_i = (const float*)d_in[13]; P.lru_lambda = (const float*)d_in[14];
    P.w_out = (const float*)d_in[15]; P.ln1_g = (const float*)d_in[16]; P.ln1_b = (const float*)d_in[17]; P.peer_w_q = (const float*)d_in[18];
    P.peer_sub_keys = (const float*)d_in[19]; P.peer_u = (const float*)d_in[20]; P.peer_v = (const float*)d_in[21]; P.ple_w_gate = (const float*)d_in[22];
    P.ple_w_proj = (const float*)d_in[23]; P.ln2_g = (const float*)d_in[24]; P.ln2_b = (const float*)d_in[25];
    P.out = (float*)d_out; P.ws = (unsigned char*)d_ws;
#if FUSED
    void* args[] = {&P};
    hipError_t e = hipLaunchCooperativeKernel((const void*)mega_kernel, dim3(grid), dim3(NTH), args, LDS_BYTES, stream);
    if (e != hipSuccess) fprintf(stderr, "cooperative launch failed: %s (grid %d)\n", hipGetErrorString(e), grid);
#else
    launch_phase<0>(P, 0, grid, stream);
    for (int layer = 0; layer < 2; ++layer) {
        launch_phase<1>(P, layer, grid, stream); launch_phase<2>(P, layer, grid, stream); launch_phase<3>(P, layer, grid, stream);
        launch_phase<4>(P, layer, grid, stream); launch_phase<5>(P, layer, grid, stream); launch_phase<6>(P, layer, grid, stream);
        launch_phase<7>(P, layer, grid, stream); launch_phase<8>(P, layer, grid, stream);
    }
#endif
}
```

```cpp
#include <hip/hip_runtime.h>
#include <hip/hip_cooperative_groups.h>
#include <cstdio>
#include <cstdint>
namespace cg = cooperative_groups;

#ifndef FUSED
#define FUSED 1
#endif
#ifndef PEER_FP4
#define PEER_FP4 1
#endif
#ifndef REPEAT_SUB
#define REPEAT_SUB 0
#endif
#ifndef REPEAT_MASK
#define REPEAT_MASK 0
#endif

constexpr int NTH = 512;
constexpr int BATCH = 2, SEQ = 16384, T = BATCH * SEQ, DM = 1024;
constexpr int INC = 2064, HP = 2048;
constexpr int C_GQ = 0, C_GK = 128, C_GV = 256, C_GG = 512, C_SQ = 768, C_SK = 1280, C_SV = 1408, C_RG = 1536, C_RR = 1792;
constexpr size_t MiB = 1u << 20;
constexpr size_t WS_WIN = 0, WS_WOUT = 9 * MiB, WS_WQG = 13 * MiB, WS_WPJ = 25 * MiB, WS_SKB = 26 * MiB, WS_WLRU = 27 * MiB, WS_WA = 27 * MiB + 262144,
                 WS_CS = 28 * MiB,
                 WS_UB = 36 * MiB, WS_VB = 68 * MiB,
                 WS_R1 = 100 * MiB,
                 WS_R2 = 244 * MiB,
                 WS_X1B = 372 * MiB,
                 WS_PE = 436 * MiB,
                 WS_BAR = 500 * MiB,
                 WS_PI = 500 * MiB + 65536,
                 WS_END = 501 * MiB;
constexpr size_t WS_H = WS_R1, WS_X1R = WS_R1, WS_EXP = WS_R1, WS_GAT = WS_R1 + 16 * MiB;
constexpr size_t WS_O = WS_R2, WS_LA = WS_R2 + 64 * MiB, WS_LU = WS_R2 + 96 * MiB, WS_Q = WS_R2, WS_XB = WS_R2;
constexpr size_t WS_PB = WS_X1B, WS_AGP = WS_X1B + 16 * MiB, WS_AGH = WS_X1B + 17 * MiB, WS_GS = WS_X1B + 18 * MiB, WS_GD = WS_X1B + 20 * MiB,
                 WS_GQT = WS_X1B + 21 * MiB, WS_GKT = WS_X1B + 29 * MiB, WS_AL = WS_X1B + 37 * MiB,     WS_GVT = WS_PE, WS_GDS = WS_PE + 16 * MiB, WS_GDEC = WS_PE + 32 * MiB;
constexpr int LDS_BYTES = 155648;
constexpr float DN_ALPHA = 1.4142135623730951f;

typedef unsigned short bf16_t;
typedef unsigned u32x4_t __attribute__((ext_vector_type(4)));
typedef unsigned u32x2_t __attribute__((ext_vector_type(2)));
typedef short bf16x8_t __attribute__((ext_vector_type(8)));
typedef float f32x4_t __attribute__((ext_vector_type(4)));
constexpr float FP8_SU = 256.f, FP8_SV = 16.f;

struct Params {
    const float *x, *p; const int* pos;
    const float *w_in, *gla_w_a2, *gla_b_a, *gla_norm_w, *swa_sinks, *lru_conv_w, *lru_conv_b, *lru_w_r, *lru_b_r, *lru_w_i, *lru_b_i,
                *lru_lambda, *w_out, *ln1_g, *ln1_b, *peer_w_q, *peer_sub_keys, *peer_u, *peer_v, *ple_w_gate, *ple_w_proj, *ln2_g, *ln2_b;
    float* out; unsigned char* ws;
    int wv, pad_;
};

__device__ const double ROPE_INV_TURNS[32] = {
    0.15915494309189535, 0.11934937021124886, 0.08949940160889101, 0.06711508300522726, 0.050329212104487035, 0.03774158471741977,
    0.0283021958306234, 0.02122365276477766, 0.015915494309189534, 0.011934937021124886, 0.008949940160889102, 0.006711508300522725,
    0.005032921210448704, 0.003774158471741977, 0.00283021958306234, 0.0021223652764777662, 0.0015915494309189536, 0.0011934937021124885,
    0.0008949940160889102, 0.0006711508300522726, 0.0005032921210448703, 0.00037741584717419774, 0.00028302195830623395,
    0.0002122365276477766, 0.00015915494309189535, 0.00011934937021124886, 8.949940160889102e-05, 6.711508300522725e-05,
    5.0329212104487035e-05, 3.774158471741978e-05, 2.8302195830623396e-05, 2.122365276477766e-05};

__device__ __forceinline__ float fast_exp(float x) { return __builtin_amdgcn_exp2f(x * 1.4426950408889634f); }
__device__ __forceinline__ float sigmoid_f(float x) { return __builtin_amdgcn_rcpf(1.f + __builtin_amdgcn_exp2f(-1.4426950408889634f * x)); }
__device__ __forceinline__ float log_sigmoid_f(float x) { return fminf(x, 0.f) - log1pf(expf(-fabsf(x))); }
typedef __fp16 h2x_t __attribute__((ext_vector_type(2)));
__device__ __forceinline__ float gelu_tanh_f(float x) { const float u = 0.7978845608028654f * (x + 0.044715f * x * x * x); return x * sigmoid_f(2.f * u); }
__device__ __forceinline__ int otid(int wv) { int l; asm volatile("v_mbcnt_lo_u32_b32 %0, -1, 0\n\tv_mbcnt_hi_u32_b32 %0, -1, %0" : "=v"(l)); return (wv << 6) | l; }
__device__ __forceinline__ float wave_sum(float v) {
#pragma unroll
    for (int o = 32; o >= 1; o >>= 1) v += __shfl_xor(v, o);
    return v;
}
__device__ __forceinline__ float wave_prefix_sum(float x) {
#define DPP_ADD_(ctrl, rmask) x += __uint_as_float((unsigned)__builtin_amdgcn_update_dpp(0, (int)__float_as_uint(x), ctrl, rmask, 0xf, false))
    DPP_ADD_(0x111, 0xf); DPP_ADD_(0x112, 0xf); DPP_ADD_(0x114, 0xf); DPP_ADD_(0x118, 0xf);
    DPP_ADD_(0x142, 0xa); DPP_ADD_(0x143, 0xc);
#undef DPP_ADD_
    return x;
}
__device__ __forceinline__ const void* uniform_ptr(const void* p) {
    const unsigned long long v = (unsigned long long)p;
    const unsigned lo = __builtin_amdgcn_readfirstlane((unsigned)v), hi = __builtin_amdgcn_readfirstlane((unsigned)(v >> 32));
    return (const void*)(((unsigned long long)hi << 32) | lo);
}
__device__ __forceinline__ unsigned pack2bf(float lo, float hi) {
    typedef float f2_t __attribute__((ext_vector_type(2))); typedef __bf16 b2_t __attribute__((ext_vector_type(2)));
    const f2_t v = {lo, hi}; const b2_t b = __builtin_convertvector(v, b2_t); return __builtin_bit_cast(unsigned, b);
}
__device__ __forceinline__ bf16_t f2bf(float f) { return (bf16_t)(pack2bf(f, 0.f) & 0xffffu); }
__device__ __forceinline__ float bf2f(bf16_t v) { return __uint_as_float((unsigned)v << 16); }
__device__ __forceinline__ float bflo(unsigned w) { return __uint_as_float(w << 16); }
__device__ __forceinline__ float bfhi(unsigned w) { return __uint_as_float(w & 0xffff0000u); }

namespace pg8 {
#define PG8_LAS __attribute__((address_space(3)))
typedef unsigned short bf16_t;
typedef short bf16x8 __attribute__((ext_vector_type(8)));
typedef float f32x4 __attribute__((ext_vector_type(4)));
typedef unsigned u32x4 __attribute__((ext_vector_type(4)));
constexpr int BM = 256, BK = 64, HALF = 128, HTB = HALF * BK * 2  , STAGE_BYTES = 8 * HTB, NXCD = 8, WGM = 8;

__host__ __device__ __forceinline__ int lds_byte(int r, int c) { const int st = (r >> 4) * 2 + (c >> 5), rr = r & 15, cc = c & 31, ob = rr * 64 + cc * 2; return st * 1024 + (ob ^ (((ob >> 9) & 1) << 5)); }
__host__ __device__ __forceinline__ void stage_rc(int b, int& R, int& C) { const int st = b / 1024, sb = b % 1024, swz = sb ^ (((sb >> 9) & 1) << 5); R = (st >> 1) * 16 + swz / 64; C = (st & 1) * 32 + (swz % 64) / 2; }
__host__ __device__ __forceinline__ int perm32(int rho) { const int n = rho >> 4, i = rho & 15; return 8 * (i >> 2) + 4 * n + (i & 3); }

struct Unit { int pm, pn; };
struct Gemm { const bf16_t* A; const bf16_t* Bt; int M, N, K, wv; };

struct StaticOrder {
    int nM, nN, nwg, G, c;
    __host__ __device__ void init(int M, int N, int G_, int c_) { nM = M / BM; nN = N / BM; nwg = nM * nN; G = G_; c = c_; }
    __host__ __device__ bool next(int i, Unit& u) const {
        const long L = (long)i * G + c; if (L >= nwg) return false;
        int wgid = (int)L; { const int q = nwg / NXCD, r = nwg % NXCD, xcd = wgid % NXCD, off = wgid / NXCD; wgid = (xcd < r ? xcd * (q + 1) : r * (q + 1) + (xcd - r) * q) + off; }
        const int nig = WGM * nN, gid = wgid / nig, fm = gid * WGM, gsz = (nM - fm) < WGM ? (nM - fm) : WGM;
        u.pm = fm + ((wgid % nig) % gsz); u.pn = (wgid % nig) / gsz; return true;
    }
    __device__ __forceinline__ void a_ready(const Unit&) const {}
    __device__ __forceinline__ void done(const Unit&) const {}
};

__device__ __forceinline__ unsigned cvt_pk_bf16(float lo, float hi) { unsigned r; asm volatile("v_cvt_pk_bf16_f32 %0, %1, %2" : "=v"(r) : "v"(lo), "v"(hi)); return r; }

template <class Epi, class Sched, bool ALIGN_EPI = false, bool SP2 = false>
__device__ __forceinline__ void gemm_phase(PG8_LAS unsigned char* lds, const Gemm g, const Sched& S, const Epi& E) {
    const int tid = otid(g.wv), wid = __builtin_amdgcn_readfirstlane(tid >> 6), lane = tid & 63, wr = wid >> 2, wc = wid & 3, fr = lane & 15, fq = lane >> 4;
    const int K = g.K, nt = K / BK;
    unsigned voffA[2], voffB[2];
#pragma unroll
    for (int i = 0; i < 2; ++i) { int R, C; stage_rc(tid * 16 + i * 8192, R, C); const int Rb = Epi::PERM ? ((R & ~31) + perm32(R & 31)) : R;
        voffA[i] = (unsigned)(R * K + C) * 2u; voffB[i] = (unsigned)(Rb * K + C) * 2u; }
    const size_t kstep = (size_t)(BK * 2);
    const size_t hstep = (size_t)HALF * K * 2;
    const size_t tstep = 2 * hstep;
    const unsigned ldsw = (unsigned)wid * 1024u;
    const int aoff = lds_byte(wr * 64 + fr, fq * 8), boff = lds_byte(wc * 32 + fr, fq * 8);
#define PG8_SA(b, h) (((b) * 2 + (h)) * HTB)
#define PG8_SB(b, h) ((4 + (b) * 2 + (h)) * HTB)
#define PG8_STAGE(bufoff, gbase, voff) do { _Pragma("unroll") for (int _i = 0; _i < 2; ++_i) \
        __builtin_amdgcn_global_load_lds((const unsigned*)((const char*)(gbase) + (voff)[_i]), (PG8_LAS unsigned*)(lds + (bufoff) + ldsw + _i * 8192), 16, 0, 0); } while (0)
#define PG8_LDA(dst, b, h) do { _Pragma("unroll") for (int m = 0; m < 4; ++m) _Pragma("unroll") for (int k = 0; k < 2; ++k) dst[m][k] = *(const PG8_LAS bf16x8*)(lds + PG8_SA(b, h) + aoff + m * 2048 + k * 1024); } while (0)
#define PG8_LDB(dst, b, h) do { _Pragma("unroll") for (int n = 0; n < 2; ++n) _Pragma("unroll") for (int k = 0; k < 2; ++k) dst[n][k] = *(const PG8_LAS bf16x8*)(lds + PG8_SB(b, h) + boff + n * 2048 + k * 1024); } while (0)
#define PG8_MMA(ai, bj, At, Bt) do { __builtin_amdgcn_s_setprio(1); _Pragma("unroll") for (int m = 0; m < 4; ++m) _Pragma("unroll") for (int n = 0; n < 2; ++n) _Pragma("unroll") for (int k = 0; k < 2; ++k) \
        acc[ai][bj][m][n] = __builtin_amdgcn_mfma_f32_16x16x32_bf16(Bt[n][k], At[m][k], acc[ai][bj][m][n], 0, 0, 0); __builtin_amdgcn_s_setprio(0); } while (0)
#define PG8_WAIT_V(n) asm volatile("s_waitcnt vmcnt(" #n ")" ::: "memory")
#define PG8_WAIT_L(n) asm volatile("s_waitcnt lgkmcnt(" #n ")" ::: "memory")
#define PG8_BAR __builtin_amdgcn_s_barrier()
#define PG8_SCHED __builtin_amdgcn_sched_barrier(0)
    Unit cur, nxt; int ui = 0;
    if (!S.next(0, cur)) return;
    f32x4 acc[2][2][4][2];
#pragma unroll
    for (int a = 0; a < 2; ++a)
#pragma unroll
        for (int b = 0; b < 2; ++b)
#pragma unroll
            for (int m = 0; m < 4; ++m)
#pragma unroll
                for (int n = 0; n < 2; ++n) acc[a][b][m][n] = (f32x4){0.f, 0.f, 0.f, 0.f};
    bf16x8 At[4][2], B0[2][2], B1[2][2];
    const char* cA = (const char*)g.A + (size_t)cur.pm * tstep; const char* cB = (const char*)g.Bt + (size_t)cur.pn * tstep;
    S.a_ready(cur);
    if constexpr (SP2) {
        PG8_STAGE(PG8_SB(0, 0), cB, voffB); PG8_STAGE(PG8_SB(0, 1), cB + hstep, voffB); PG8_STAGE(PG8_SA(0, 0), cA, voffA); PG8_STAGE(PG8_SA(0, 1), cA + hstep, voffA);
        if (wr == 1) PG8_BAR;
        PG8_WAIT_V(2); PG8_BAR;
        PG8_STAGE(PG8_SB(1, 0), cB + kstep, voffB); PG8_STAGE(PG8_SA(1, 0), cA + kstep, voffA); PG8_STAGE(PG8_SB(1, 1), cB + hstep + kstep, voffB);
        PG8_WAIT_V(6); PG8_BAR;
    } else {
        PG8_STAGE(PG8_SB(0, 0), cB, voffB); PG8_STAGE(PG8_SA(0, 0), cA, voffA); PG8_STAGE(PG8_SB(0, 1), cB + hstep, voffB); PG8_STAGE(PG8_SA(0, 1), cA + hstep, voffA);
        if (wr == 1) PG8_BAR;
        PG8_WAIT_V(4); PG8_BAR;
        PG8_STAGE(PG8_SB(1, 0), cB + kstep, voffB); PG8_STAGE(PG8_SA(1, 0), cA + kstep, voffA); PG8_STAGE(PG8_SB(1, 1), cB + hstep + kstep, voffB);
        PG8_WAIT_V(6); PG8_BAR;
    }
    for (;;) {
        const bool has_next = S.next(ui + 1, nxt);
        const char* nA = has_next ? (const char*)g.A + (size_t)nxt.pm * tstep : cA; const char* nB = has_next ? (const char*)g.Bt + (size_t)nxt.pn * tstep : cB;
        for (int t = 0; t < nt; t += 2) {
            const bool last = (t == nt - 2);
            const char* a1 = cA + (size_t)(t + 1) * kstep;
            const char* a2 = last ? nA : cA + (size_t)(t + 2) * kstep; const char* b2 = last ? nB : cB + (size_t)(t + 2) * kstep;
            const char* a3 = a2 + kstep; const char* b3 = b2 + kstep;
            if (last && has_next) S.a_ready(nxt);
            if constexpr (SP2) {
            PG8_LDB(B0, 0, 0); PG8_LDB(B1, 0, 1); PG8_SCHED; PG8_LDA(At, 0, 0); PG8_STAGE(PG8_SA(1, 1), a1 + hstep, voffA);
            PG8_WAIT_V(8); PG8_WAIT_L(0); PG8_BAR; PG8_MMA(0, 0, At, B0); PG8_MMA(0, 1, At, B1); PG8_BAR; PG8_SCHED;
            PG8_LDA(At, 0, 1); PG8_STAGE(PG8_SB(0, 0), b2, voffB); PG8_STAGE(PG8_SB(0, 1), b2 + hstep, voffB); PG8_STAGE(PG8_SA(0, 0), a2, voffA);
            PG8_WAIT_V(8); PG8_WAIT_L(0); PG8_BAR; PG8_MMA(1, 0, At, B0); PG8_MMA(1, 1, At, B1); PG8_BAR; PG8_SCHED;
            PG8_LDB(B0, 1, 0); PG8_LDB(B1, 1, 1); PG8_SCHED; PG8_LDA(At, 1, 0); PG8_STAGE(PG8_SA(0, 1), a2 + hstep, voffA);
            PG8_WAIT_V(8); PG8_WAIT_L(0); PG8_BAR; PG8_MMA(0, 0, At, B0); PG8_MMA(0, 1, At, B1); PG8_BAR; PG8_SCHED;
            PG8_LDA(At, 1, 1); PG8_STAGE(PG8_SB(1, 0), b3, voffB); PG8_STAGE(PG8_SB(1, 1), b3 + hstep, voffB); PG8_STAGE(PG8_SA(1, 0), a3, voffA);
            PG8_WAIT_V(8); PG8_WAIT_L(0); PG8_BAR; PG8_MMA(1, 0, At, B0); PG8_MMA(1, 1, At, B1); PG8_BAR; PG8_SCHED;
            } else {
            PG8_LDB(B0, 0, 0); PG8_SCHED; PG8_LDA(At, 0, 0); PG8_STAGE(PG8_SA(1, 1), a1 + hstep, voffA);
            PG8_WAIT_L(8); PG8_BAR; PG8_WAIT_L(0); PG8_MMA(0, 0, At, B0); PG8_BAR; PG8_SCHED;
            PG8_LDB(B1, 0, 1); PG8_STAGE(PG8_SB(0, 0), b2, voffB);
            PG8_BAR; PG8_WAIT_L(0); PG8_MMA(0, 1, At, B1); PG8_BAR;
            PG8_LDA(At, 0, 1); PG8_STAGE(PG8_SA(0, 0), a2, voffA);
            PG8_BAR; PG8_WAIT_L(0); PG8_MMA(1, 0, At, B0); PG8_BAR; PG8_SCHED;
            PG8_STAGE(PG8_SB(0, 1), b2 + hstep, voffB);
            PG8_WAIT_V(6); PG8_BAR; PG8_MMA(1, 1, At, B1); PG8_BAR;
            PG8_LDB(B0, 1, 0); PG8_SCHED; PG8_LDA(At, 1, 0); PG8_STAGE(PG8_SA(0, 1), a2 + hstep, voffA);
            PG8_WAIT_L(8); PG8_BAR; PG8_WAIT_L(0); PG8_MMA(0, 0, At, B0); PG8_BAR; PG8_SCHED;
            PG8_LDB(B1, 1, 1); PG8_STAGE(PG8_SB(1, 0), b3, voffB);
            PG8_BAR; PG8_WAIT_L(0); PG8_MMA(0, 1, At, B1); PG8_BAR;
            PG8_LDA(At, 1, 1); PG8_STAGE(PG8_SA(1, 0), a3, voffA);
            PG8_BAR; PG8_WAIT_L(0); PG8_MMA(1, 0, At, B0); PG8_BAR; PG8_SCHED;
            PG8_STAGE(PG8_SB(1, 1), b3 + hstep, voffB);
            PG8_WAIT_V(6); PG8_BAR; PG8_MMA(1, 1, At, B1); PG8_BAR;
            }
        }
        if constexpr (ALIGN_EPI) { if (wr == 0) PG8_BAR; }
        if constexpr (!Epi::AFTER_DRAIN) { E(acc, cur, wr, wc, fr, fq); S.done(cur); }
        if (!has_next) break;
#pragma unroll
        for (int a = 0; a < 2; ++a)
#pragma unroll
            for (int b = 0; b < 2; ++b)
#pragma unroll
                for (int m = 0; m < 4; ++m)
#pragma unroll
                    for (int n = 0; n < 2; ++n) acc[a][b][m][n] = (f32x4){0.f, 0.f, 0.f, 0.f};
        cur = nxt; cA = nA; cB = nB; ++ui;
        if constexpr (ALIGN_EPI) { if (wr == 1) PG8_BAR; }
    }
    PG8_WAIT_V(0);
    if constexpr (!ALIGN_EPI) { if (wr == 0) PG8_BAR; }
    PG8_BAR;
    if constexpr (Epi::AFTER_DRAIN) { E.fused(acc, cur, wr, wc, fr, fq, lds, wid, lane); S.done(cur); }
#undef PG8_SA
#undef PG8_SB
#undef PG8_STAGE
#undef PG8_LDA
#undef PG8_LDB
#undef PG8_MMA
#undef PG8_WAIT_V
#undef PG8_WAIT_L
#undef PG8_BAR
#undef PG8_SCHED
}
}


namespace pg8 {
struct EpiBf16P {
    static constexpr bool PERM = true, AFTER_DRAIN = false;
    bf16_t* O; int ldc;
    __device__ __forceinline__ void operator()(const f32x4 (&acc)[2][2][4][2], const Unit& u, int wr, int wc, int fr, int fq) const {
        const int row0 = u.pm * BM + wr * 64 + fr, col0 = u.pn * BM + wc * 32 + 8 * fq;
#pragma unroll
        for (int ai = 0; ai < 2; ++ai)
#pragma unroll
            for (int m = 0; m < 4; ++m) { bf16_t* rowp = O + (size_t)(row0 + ai * HALF + m * 16) * ldc + col0;
#pragma unroll
                for (int bj = 0; bj < 2; ++bj) { const f32x4 v0 = acc[ai][bj][m][0], v1 = acc[ai][bj][m][1];
                    u32x4 w; w.x = pack2bf(v0[0], v0[1]); w.y = pack2bf(v0[2], v0[3]); w.z = pack2bf(v1[0], v1[1]); w.w = pack2bf(v1[2], v1[3]);
                    *(u32x4*)(rowp + bj * HALF) = w; } }
    }
};
struct EpiF32P {
    static constexpr bool PERM = false, AFTER_DRAIN = false;
    float* C; int ldc;
    __device__ __forceinline__ void operator()(const f32x4 (&acc)[2][2][4][2], const Unit& u, int wr, int wc, int fr, int fq) const {
        const int row0 = u.pm * BM + wr * 64 + fr, col0 = u.pn * BM + wc * 32 + 4 * fq;
#pragma unroll
        for (int ai = 0; ai < 2; ++ai)
#pragma unroll
            for (int m = 0; m < 4; ++m) { float* rowp = C + (size_t)(row0 + ai * HALF + m * 16) * ldc + col0;
#pragma unroll
                for (int bj = 0; bj < 2; ++bj)
#pragma unroll
                    for (int n = 0; n < 2; ++n) *(f32x4*)(rowp + bj * HALF + n * 16) = acc[ai][bj][m][n]; }
    }
};
__device__ __forceinline__ float fast_sigmoid(float x) { return __builtin_amdgcn_rcpf(1.f + __builtin_amdgcn_exp2f(-1.4426950408889634f * x)); }
struct EpiQG {
    static constexpr bool PERM = true, AFTER_DRAIN = false;
    bf16_t* Q; bf16_t* PE;
    __device__ __forceinline__ void operator()(const f32x4 (&acc)[2][2][4][2], const Unit& u, int wr, int wc, int fr, int fq) const {
        const int row0 = u.pm * BM + wr * 64 + fr;
        if (u.pn < 8) {
            const int col0 = u.pn * BM + wc * 32 + 8 * fq;
#pragma unroll
            for (int ai = 0; ai < 2; ++ai)
#pragma unroll
                for (int m = 0; m < 4; ++m) { bf16_t* rowp = Q + (size_t)(row0 + ai * HALF + m * 16) * 2048 + col0;
#pragma unroll
                    for (int bj = 0; bj < 2; ++bj) { const f32x4 v0 = acc[ai][bj][m][0], v1 = acc[ai][bj][m][1];
                        u32x4 w; w.x = pack2bf(v0[0], v0[1]); w.y = pack2bf(v0[2], v0[3]); w.z = pack2bf(v1[0], v1[1]); w.w = pack2bf(v1[2], v1[3]);
                        *(u32x4*)(rowp + bj * HALF) = w; } }
        } else {
            const int col0 = (u.pn - 8) * BM + wc * 32 + 8 * fq;
#pragma unroll
            for (int ai = 0; ai < 2; ++ai)
#pragma unroll
                for (int m = 0; m < 4; ++m) { bf16_t* rowp = PE + (size_t)(row0 + ai * HALF + m * 16) * 1024 + col0;
#pragma unroll
                    for (int bj = 0; bj < 2; ++bj) { const f32x4 v0 = acc[ai][bj][m][0], v1 = acc[ai][bj][m][1];
                        const u32x4 pp = *(const u32x4*)(rowp + bj * HALF);
                        u32x4 w;
                        w.x = pack2bf(fast_sigmoid(v0[0]) * bflo(pp.x), fast_sigmoid(v0[1]) * bfhi(pp.x));
                        w.y = pack2bf(fast_sigmoid(v0[2]) * bflo(pp.y), fast_sigmoid(v0[3]) * bfhi(pp.y));
                        w.z = pack2bf(fast_sigmoid(v1[0]) * bflo(pp.z), fast_sigmoid(v1[1]) * bfhi(pp.z));
                        w.w = pack2bf(fast_sigmoid(v1[2]) * bflo(pp.w), fast_sigmoid(v1[3]) * bfhi(pp.w));
                        *(u32x4*)(rowp + bj * HALF) = w; } }
        }
    }
};
}

template <class Epi>
__device__ __forceinline__ void run_gemm(float* smem, const bf16_t* A, const bf16_t* Bt, int M, int N, int K, const Epi& E, int wv) {
    pg8::Gemm g{A, Bt, M, N, K, wv};
    pg8::StaticOrder S; S.init(M, N, (int)gridDim.x, (int)blockIdx.x);
    pg8::gemm_phase<Epi, pg8::StaticOrder, true, true>((PG8_LAS unsigned char*)smem, g, S, E);
    __syncthreads();
}

__device__ __forceinline__ void rope_table(const Params& P, int gtid, int gnth) {
    float2* cs = (float2*)(P.ws + WS_CS);
    for (int idx = gtid; idx < T * 32; idx += gnth) {
        const int t = idx >> 5, i = idx & 31;
        const double q4 = (double)P.pos[t] * ROPE_INV_TURNS[i] * 4.0;
        const double qn = rint(q4);
        const float th = (float)(q4 - qn) * 1.5707963267948966f;
        const float t2 = th * th;
        const float s = th * (1.f + t2 * (-1.f / 6.f + t2 * (1.f / 120.f + t2 * (-1.f / 5040.f + t2 * (1.f / 362880.f)))));
        const float c = 1.f + t2 * (-0.5f + t2 * (1.f / 24.f + t2 * (-1.f / 720.f + t2 * (1.f / 40320.f + t2 * (-1.f / 3628800.f)))));
        const int qi = ((int)(long long)qn) & 3;
        const float cc = (qi == 0) ? c : (qi == 1) ? -s : (qi == 2) ? -c : s;
        const float ss = (qi == 0) ? s : (qi == 1) ? c : (qi == 2) ? -s : -c;
        cs[idx] = make_float2(cc, ss);
    }
}
__device__ __forceinline__ void transpose_item(const float* __restrict__ W, int K, int ldw, int col0, int nvalid, bf16_t* __restrict__ WT, int row_off, int nblk, int item, float* smem, int tid) {
    const int kb = item / nblk, nb = item % nblk, k0 = kb * 64, n0 = nb * 64;
    {
        const int nn = tid & 63, kk0 = tid >> 6;
#pragma unroll
        for (int i = 0; i < 8; ++i) { const int kk = kk0 + i * 8; const int n = n0 + nn; smem[kk * 65 + nn] = (n < nvalid) ? W[(size_t)(k0 + kk) * ldw + col0 + n] : 0.f; }
    }
    __syncthreads();
    {
        const int kk2 = (tid & 31) * 2, nn0 = tid >> 5;
#pragma unroll
        for (int i = 0; i < 4; ++i) { const int nn = nn0 + i * 16;
            *(unsigned*)(WT + (size_t)(row_off + n0 + nn) * K + k0 + kk2) = pack2bf(smem[kk2 * 65 + nn], smem[(kk2 + 1) * 65 + nn]); }
    }
    __syncthreads();
}
__device__ __forceinline__ void transpose_item4(const float* __restrict__ W, int K, int ldw, int col0, bf16_t* __restrict__ WT, int row_off, int nblk4, int item, float* smem, int tid) {
    const int kb = item / nblk4, nb = item % nblk4, k0 = kb * 64, n0 = nb * 256;
    {
        const int nn = tid & 255, kk0 = tid >> 8;
#pragma unroll
        for (int i = 0; i < 32; ++i) { const int kk = kk0 + i * 2; smem[kk * 257 + nn] = W[(size_t)(k0 + kk) * ldw + col0 + n0 + nn]; }
    }
    __syncthreads();
    {
        const int kk2 = (tid & 31) * 2, nn0 = tid >> 5;
#pragma unroll
        for (int i = 0; i < 16; ++i) { const int nn = nn0 + i * 16;
            *(unsigned*)(WT + (size_t)(row_off + n0 + nn) * K + k0 + kk2) = pack2bf(smem[kk2 * 257 + nn], smem[(kk2 + 1) * 257 + nn]); }
    }
    __syncthreads();
}
__device__ __forceinline__ void convert_bf16(const float* __restrict__ src, bf16_t* __restrict__ dst, size_t n, int gtid, int gnth) {
    for (size_t i = (size_t)gtid * 8; i < n; i += (size_t)gnth * 8) {
        const float4 a = *(const float4*)(src + i), b = *(const float4*)(src + i + 4);
        u32x4_t w; w.x = pack2bf(a.x, a.y); w.y = pack2bf(a.z, a.w); w.z = pack2bf(b.x, b.y); w.w = pack2bf(b.z, b.w);
        *(u32x4_t*)(dst + i) = w;
    }
}
__device__ __forceinline__ void convert_fp8(const float* __restrict__ src, unsigned char* __restrict__ dst, size_t n, float scale, int gtid, int gnth) {
    for (size_t i = (size_t)gtid * 16; i < n; i += (size_t)gnth * 16) {
        u32x4_t w;
#pragma unroll
        for (int j = 0; j < 4; ++j) {
            const float4 a = *(const float4*)(src + i + j * 4);
            const float c0 = fminf(fmaxf(a.x * scale, -448.f), 448.f), c1 = fminf(fmaxf(a.y * scale, -448.f), 448.f);
            const float c2 = fminf(fmaxf(a.z * scale, -448.f), 448.f), c3 = fminf(fmaxf(a.w * scale, -448.f), 448.f);
            int v = 0;
            v = __builtin_amdgcn_cvt_pk_fp8_f32(c0, c1, v, false);
            v = __builtin_amdgcn_cvt_pk_fp8_f32(c2, c3, v, true);
            w[j] = (unsigned)v;
        }
        *(u32x4_t*)(dst + i) = w;
    }
}
typedef int v8i_t __attribute__((ext_vector_type(8)));
__device__ __forceinline__ unsigned mx_code(unsigned q) { return q < 126u ? q + 1u : (q == 126u ? 0x81u : 0x82u); }
__device__ __forceinline__ void calibrate_mx(const Params& P) {
    const int tid = otid(P.wv);
    if ((int)blockIdx.x * 8 >= 128) return;
    unsigned char* PI = (unsigned char*)(P.ws + WS_PI);
    const int lane = tid & 63, kb = lane >> 4;
    v8i_t bv;
#pragma unroll
    for (int t = 0; t < 8; ++t) { unsigned w = 0; for (int bb = 0; bb < 4; ++bb) w |= mx_code((unsigned)(kb * 32 + 4 * t + bb)) << (8 * bb); bv[t] = (int)w; }
    const unsigned c_lo = mx_code((unsigned)lane), c_hi = mx_code((unsigned)lane + 64u);
    const float cand_lo = __builtin_amdgcn_cvt_pk_f32_fp8((int)(c_lo | (c_lo << 8)), false)[0], cand_hi = __builtin_amdgcn_cvt_pk_f32_fp8((int)(c_hi | (c_hi << 8)), false)[0];
    for (int p = blockIdx.x * 8 + (tid >> 6); p < 128; p += gridDim.x * 8) {
        const int pe = (kb == (p >> 5)) ? (p & 31) : -1;
        v8i_t av = {0, 0, 0, 0, 0, 0, 0, 0};
#pragma unroll
        for (int dI = 0; dI < 4; ++dI) {
            unsigned v = 0;
#define OH_(sx) v = __builtin_amdgcn_cvt_scalef32_pk_fp4_f32(v, (pe == 8 * dI + 2 * sx) ? 1.0f : 0.0f, (pe == 8 * dI + 2 * sx + 1) ? 1.0f : 0.0f, 1.0f, sx)
            OH_(0); OH_(1); OH_(2); OH_(3);
#undef OH_
            av[dI] = (int)v;
        }
        f32x4_t d = (f32x4_t){0.f, 0.f, 0.f, 0.f};
        d = __builtin_amdgcn_mfma_scale_f32_16x16x128_f8f6f4(av, bv, d, 4, 0, 0, 0x7F7F7F7F, 0, 0x7F7F7F7F);
        const float val = __uint_as_float((unsigned)__builtin_amdgcn_readfirstlane((int)__float_as_uint(d[0])));
        const unsigned long long m_lo = __ballot(val == cand_lo), m_hi = __ballot(val == cand_hi);
        const unsigned q = m_lo ? (unsigned)__builtin_ctzll(m_lo) : (m_hi ? 64u + (unsigned)__builtin_ctzll(m_hi) : (unsigned)p);
        if (lane == 0) PI[p] = (unsigned char)q;
    }
}
__device__ __forceinline__ void phase_prologue(const Params& P, float* smem) {
    const int tid = otid(P.wv), gtid = blockIdx.x * NTH + tid, gnth = gridDim.x * NTH;
    calibrate_mx(P);
    rope_table(P, gtid, gnth);
    convert_bf16(P.x, (bf16_t*)P.out, (size_t)T * DM, gtid, gnth);
    convert_bf16(P.peer_sub_keys, (bf16_t*)(P.ws + WS_SKB), (size_t)2 * 8 * 2 * 128 * 128, gtid, gnth);
    for (int i = gtid; i < 2 * 2 * 4 * 4096; i += gnth) {
        const int ii = i & 63, jj = (i >> 6) & 63, blk = (i >> 12) & 3, gt = (i >> 14) & 1, l = i >> 15;
        const float* src = (gt == 0) ? P.lru_w_r : P.lru_w_i;
        ((bf16_t*)(P.ws + WS_WLRU))[i] = f2bf(src[((size_t)l * 4 + blk) * 4096 + ii * 64 + jj]);
    }
    constexpr int I_INA = 16 * 3, I_INB = 16 * 5, I_INC = 16, I_OUT = 64, I_Q = 128, I_G = 64, I_PJ = 16, I_L = I_INA + I_INB + I_INC + I_OUT + I_Q + I_G + I_PJ;
    for (int it = blockIdx.x; it < 2 * I_L; it += gridDim.x) {
        const int l = it / I_L; int r = it % I_L;
        const float* win = P.w_in + (size_t)l * DM * INC; bf16_t* wint = (bf16_t*)(P.ws + WS_WIN) + (size_t)l * HP * DM;
        if (r < I_INA) { transpose_item4(win, DM, INC, 0, wint, 0, 3, r, smem, tid); continue; } r -= I_INA;
        if (r < I_INB) { transpose_item4(win, DM, INC, 784, wint, 768, 5, r, smem, tid); continue; } r -= I_INB;
        if (r < I_INC) { transpose_item(win, DM, INC, 768, 16, (bf16_t*)(P.ws + WS_WA) + (size_t)l * 64 * DM, 0, 1, r, smem, tid); continue; } r -= I_INC;
        if (r < I_OUT) { transpose_item4(P.w_out + (size_t)l * DM * DM, DM, DM, 0, (bf16_t*)(P.ws + WS_WOUT) + (size_t)l * DM * DM, 0, 4, r, smem, tid); continue; } r -= I_OUT;
        if (r < I_Q) { transpose_item4(P.peer_w_q + (size_t)l * DM * 2048, DM, 2048, 0, (bf16_t*)(P.ws + WS_WQG) + (size_t)l * 3072 * DM, 0, 8, r, smem, tid); continue; } r -= I_Q;
        if (r < I_G) { transpose_item4(P.ple_w_gate + (size_t)l * DM * DM, DM, DM, 0, (bf16_t*)(P.ws + WS_WQG) + (size_t)l * 3072 * DM, 2048, 4, r, smem, tid); continue; } r -= I_G;
        transpose_item4(P.ple_w_proj + (size_t)l * 256 * DM, 256, DM, 0, (bf16_t*)(P.ws + WS_WPJ) + (size_t)l * DM * 256, 0, 4, r, smem, tid);
    }
}

__device__ __forceinline__ void alow_item(const Params& P, int layer, int item) {
    const bf16_t* XB = (const bf16_t*)P.out;
    const bf16_t* WA = (const bf16_t*)(P.ws + WS_WA) + (size_t)layer * 64 * DM;
    bf16_t* AL = (bf16_t*)(P.ws + WS_AL);
    const int tid = otid(P.wv), lane = tid & 63, w = tid >> 6, r16 = lane & 15, g = lane >> 4;
    const size_t tok0 = (size_t)item * 128 + 16 * w;
    const bf16_t* ap = XB + (tok0 + r16) * DM + 8 * g;
    const bf16_t* bp = WA + (size_t)r16 * DM + 8 * g;
    f32x4_t acc = (f32x4_t){0.f, 0.f, 0.f, 0.f};
#pragma unroll 8
    for (int ks = 0; ks < 32; ++ks) {
        const bf16x8_t af = *(const bf16x8_t*)(ap + 32 * ks), bfv = *(const bf16x8_t*)(bp + 32 * ks);
        acc = __builtin_amdgcn_mfma_f32_16x16x32_bf16(af, bfv, acc, 0, 0, 0);
    }
#pragma unroll
    for (int rg = 0; rg < 4; ++rg) AL[(tok0 + 4 * g + rg) * 16 + r16] = f2bf(acc[rg]);
}

constexpr int GLW = 1024, GLR = 3584;
__device__ __forceinline__ float fast_log_sigmoid(float z) {
    const float e = __builtin_amdgcn_exp2f(-fabsf(z) * 1.4426950408889634f);
    return fminf(z, 0.f) - __builtin_amdgcn_logf(1.f + e) * 0.6931471805599453f;
}
__device__ __forceinline__ void gla_pre_item(const Params& P, int layer, float* sm, int item) {
    const int bh = item >> 5, hd = bh & 3, b = bh >> 2, seg = item & 31;
    const bf16_t* H = (const bf16_t*)(P.ws + WS_H);
    bf16_t* QT = (bf16_t*)(P.ws + WS_GQT);
    bf16_t* KT = (bf16_t*)(P.ws + WS_GKT);
    bf16_t* VT = (bf16_t*)(P.ws + WS_GVT);
    float* DS = (float*)(P.ws + WS_GDS);
    float* DEC = (float*)(P.ws + WS_GDEC);
    float* GS = (float*)(P.ws + WS_GS);
    float* GD = (float*)(P.ws + WS_GD);
    const int tid = otid(P.wv), lane = tid & 63, w = __builtin_amdgcn_readfirstlane(tid >> 6), r16 = lane & 15, g = lane >> 4;
    const int chunk = seg * 8 + w;
    const size_t tok = (size_t)b * SEQ + (size_t)chunk * 64 + lane;
    const bf16_t* hrow = H + tok * HP;
    u32x4_t a0, a1, wq4[4], wk4[4], wv8[8];
    { const bf16_t* alr = (const bf16_t*)(P.ws + WS_AL) + tok * 16; a0 = *(const u32x4_t*)alr; a1 = *(const u32x4_t*)(alr + 8); }
#pragma unroll
    for (int j = 0; j < 4; ++j) { wq4[j] = *(const u32x4_t*)(hrow + C_GQ + hd * 32 + j * 8); wk4[j] = *(const u32x4_t*)(hrow + C_GK + hd * 32 + j * 8); }
#pragma unroll
    for (int j = 0; j < 8; ++j) wv8[j] = *(const u32x4_t*)(hrow + C_GV + hd * 64 + j * 8);
    { const int r = tid >> 5, d = tid & 31; sm[tid] = P.gla_w_a2[layer * 2048 + r * 128 + hd * 32 + d]; }
    if (tid < 32) sm[512 + tid] = P.gla_b_a[layer * 128 + hd * 32 + tid];
    __syncthreads();
    float bc[32];
    {
        float al[16];
        {
          al[0] = bflo(a0.x); al[1] = bfhi(a0.x); al[2] = bflo(a0.y); al[3] = bfhi(a0.y); al[4] = bflo(a0.z); al[5] = bfhi(a0.z); al[6] = bflo(a0.w); al[7] = bfhi(a0.w);
          al[8] = bflo(a1.x); al[9] = bfhi(a1.x); al[10] = bflo(a1.y); al[11] = bfhi(a1.y); al[12] = bflo(a1.z); al[13] = bfhi(a1.z); al[14] = bflo(a1.w); al[15] = bfhi(a1.w); }
#pragma unroll
        for (int d4 = 0; d4 < 8; ++d4) {
            float4 z = *(const float4*)(sm + 512 + d4 * 4);
#pragma unroll
            for (int r = 0; r < 16; ++r) { const float4 wv = *(const float4*)(sm + r * 32 + d4 * 4); z.x += al[r] * wv.x; z.y += al[r] * wv.y; z.z += al[r] * wv.z; z.w += al[r] * wv.w; }
            bc[d4 * 4 + 0] = fast_log_sigmoid(z.x) * 0.0625f; bc[d4 * 4 + 1] = fast_log_sigmoid(z.y) * 0.0625f;
            bc[d4 * 4 + 2] = fast_log_sigmoid(z.z) * 0.0625f; bc[d4 * 4 + 3] = fast_log_sigmoid(z.w) * 0.0625f;
        }
    }
#pragma unroll
    for (int d = 0; d < 32; ++d) bc[d] = wave_prefix_sum(bc[d]);
    bf16_t* khT = (bf16_t*)(sm + GLW + w * GLR);
    bf16_t* vT = khT + 32 * 72;
    {
        float qv[32], kv[32];
#pragma unroll
        for (int j = 0; j < 4; ++j) {
            const u32x4_t wq = wq4[j], wk = wk4[j];
            qv[j * 8 + 0] = bflo(wq.x); qv[j * 8 + 1] = bfhi(wq.x); qv[j * 8 + 2] = bflo(wq.y); qv[j * 8 + 3] = bfhi(wq.y);
            qv[j * 8 + 4] = bflo(wq.z); qv[j * 8 + 5] = bfhi(wq.z); qv[j * 8 + 6] = bflo(wq.w); qv[j * 8 + 7] = bfhi(wq.w);
            kv[j * 8 + 0] = bflo(wk.x); kv[j * 8 + 1] = bfhi(wk.x); kv[j * 8 + 2] = bflo(wk.y); kv[j * 8 + 3] = bfhi(wk.y);
            kv[j * 8 + 4] = bflo(wk.z); kv[j * 8 + 5] = bfhi(wk.z); kv[j * 8 + 6] = bflo(wk.w); kv[j * 8 + 7] = bfhi(wk.w);
        }
        float kh[32];
#pragma unroll
        for (int d = 0; d < 32; ++d) {
            const float bl = __uint_as_float((unsigned)__builtin_amdgcn_readlane((int)__float_as_uint(bc[d]), 63));
            const float eb = __builtin_amdgcn_exp2f(bc[d] * 1.4426950408889634f), enb = __builtin_amdgcn_exp2f(-bc[d] * 1.4426950408889634f);
            kh[d] = kv[d] * __builtin_amdgcn_exp2f((bl - bc[d]) * 1.4426950408889634f);
            qv[d] = qv[d] * 0.17677669529663687f * eb; kv[d] = kv[d] * enb;
        }
#pragma unroll
        for (int j = 0; j < 4; ++j) {
            u32x4_t wq, wk;
            wq.x = pack2bf(qv[j * 8 + 0], qv[j * 8 + 1]); wq.y = pack2bf(qv[j * 8 + 2], qv[j * 8 + 3]); wq.z = pack2bf(qv[j * 8 + 4], qv[j * 8 + 5]); wq.w = pack2bf(qv[j * 8 + 6], qv[j * 8 + 7]);
            wk.x = pack2bf(kv[j * 8 + 0], kv[j * 8 + 1]); wk.y = pack2bf(kv[j * 8 + 2], kv[j * 8 + 3]); wk.z = pack2bf(kv[j * 8 + 4], kv[j * 8 + 5]); wk.w = pack2bf(kv[j * 8 + 6], kv[j * 8 + 7]);
            *(u32x4_t*)(QT + ((size_t)hd * T + tok) * 32 + j * 8) = wq; *(u32x4_t*)(KT + ((size_t)hd * T + tok) * 32 + j * 8) = wk;
        }
#pragma unroll
        for (int d = 0; d < 32; ++d) khT[d * 72 + lane] = f2bf(kh[d]);
    }
    bf16_t* VTc = VT + ((size_t)bh * 256 + chunk) * 4096;
#pragma unroll
    for (int j = 0; j < 8; ++j) {
        const u32x4_t wv = wv8[j];
        const unsigned ww[4] = {wv.x, wv.y, wv.z, wv.w};
#pragma unroll
        for (int q = 0; q < 4; ++q) {
            const bf16_t lo = (bf16_t)(ww[q] & 0xffffu), hi = (bf16_t)(ww[q] >> 16);
            const int dv = j * 8 + q * 2;
            vT[dv * 72 + lane] = lo; vT[(dv + 1) * 72 + lane] = hi;
        }
    }
#pragma unroll
    for (int k = 0; k < 8; ++k) {
        const int dv = 8 * k + (lane >> 3);
        *(u32x4_t*)(VTc + dv * 64 + (lane & 7) * 8) = *(const u32x4_t*)(vT + dv * 72 + (lane & 7) * 8);
    }
    if (lane == 63) {
        float* dg = DEC + ((size_t)bh * 256 + chunk) * 32;
#pragma unroll
        for (int d = 0; d < 32; ++d) { const float e = __builtin_amdgcn_exp2f(bc[d] * 1.4426950408889634f); dg[d] = e; sm[544 + w * 32 + d] = e; }
    }
    f32x4_t acc[2][4];
#pragma unroll
    for (int mt = 0; mt < 2; ++mt)
#pragma unroll
        for (int nt = 0; nt < 4; ++nt) acc[mt][nt] = (f32x4_t){0.f, 0.f, 0.f, 0.f};
#pragma unroll
    for (int ks = 0; ks < 2; ++ks) {
        bf16x8_t af[2], bfv[4];
#pragma unroll
        for (int mt = 0; mt < 2; ++mt) af[mt] = *(const bf16x8_t*)(khT + (16 * mt + r16) * 72 + 32 * ks + 8 * g);
#pragma unroll
        for (int nt = 0; nt < 4; ++nt) bfv[nt] = *(const bf16x8_t*)(vT + (16 * nt + r16) * 72 + 32 * ks + 8 * g);
#pragma unroll
        for (int mt = 0; mt < 2; ++mt)
#pragma unroll
            for (int nt = 0; nt < 4; ++nt) acc[mt][nt] = __builtin_amdgcn_mfma_f32_16x16x32_bf16(af[mt], bfv[nt], acc[mt][nt], 0, 0, 0);
    }
    float* DSc = DS + ((size_t)bh * 256 + chunk) * 2048;
    float* dsl = sm + GLW + w * GLR;
#pragma unroll
    for (int mt = 0; mt < 2; ++mt)
#pragma unroll
        for (int nt = 0; nt < 4; ++nt)
#pragma unroll
            for (int rg = 0; rg < 4; ++rg) { const int idx = (16 * mt + 4 * g + rg) * 64 + 16 * nt + r16; dsl[idx] = acc[mt][nt][rg]; }
#pragma unroll
    for (int k = 0; k < 8; ++k) *(float4*)(DSc + k * 256 + lane * 4) = *(const float4*)(dsl + k * 256 + lane * 4);
    __syncthreads();
    {
        const int d = tid >> 4, v4 = (tid & 15) * 4;
        float4 S4 = make_float4(0.f, 0.f, 0.f, 0.f); float pd = 1.f;
#pragma unroll
        for (int c = 0; c < 8; ++c) {
            const float e = sm[544 + c * 32 + d];
            const float4 dv4 = *(const float4*)(sm + GLW + c * GLR + d * 64 + v4);
            S4.x = e * S4.x + dv4.x; S4.y = e * S4.y + dv4.y; S4.z = e * S4.z + dv4.z; S4.w = e * S4.w + dv4.w; pd *= e;
        }
        *(float4*)(GS + (size_t)item * 2048 + d * 64 + v4) = S4;
        if ((tid & 15) == 0) GD[item * 32 + d] = pd;
    }
    __syncthreads();
}
__device__ __forceinline__ void gla_out_item(const Params& P, int layer, float* sm, int item) {
    const int bh = item >> 5, hd = bh & 3, b = bh >> 2, seg = item & 31;
    const bf16_t* H = (const bf16_t*)(P.ws + WS_H);
    bf16_t* O = (bf16_t*)(P.ws + WS_O);
    const bf16_t* QT = (const bf16_t*)(P.ws + WS_GQT);
    const bf16_t* KT = (const bf16_t*)(P.ws + WS_GKT);
    const bf16_t* VT = (const bf16_t*)(P.ws + WS_GVT);
    const float* DS = (const float*)(P.ws + WS_GDS);
    const float* DEC = (const float*)(P.ws + WS_GDEC);
    const float* GS = (const float*)(P.ws + WS_GS);
    const float* GD = (const float*)(P.ws + WS_GD);
    const int tid = otid(P.wv), lane = tid & 63, w = __builtin_amdgcn_readfirstlane(tid >> 6), r16 = lane & 15, g = lane >> 4;
    const int chunk = seg * 8 + w;
    const size_t t0 = (size_t)b * SEQ + (size_t)chunk * 64;
    bf16x8_t aq[4], bk[4];
#pragma unroll
    for (int mt = 0; mt < 4; ++mt) {
        aq[mt] = *(const bf16x8_t*)(QT + ((size_t)hd * T + t0 + 16 * mt + r16) * 32 + 8 * g);
        bk[mt] = *(const bf16x8_t*)(KT + ((size_t)hd * T + t0 + 16 * mt + r16) * 32 + 8 * g);
    }
    const bf16_t* VTc = VT + ((size_t)bh * 256 + chunk) * 4096;
    bf16x8_t vf[4][2];
#pragma unroll
    for (int nt = 0; nt < 4; ++nt)
#pragma unroll
        for (int ks = 0; ks < 2; ++ks) vf[nt][ks] = *(const bf16x8_t*)(VTc + (16 * nt + r16) * 64 + 32 * ks + 8 * g);
    u32x4_t gq[8];
#pragma unroll
    for (int k = 0; k < 8; ++k) gq[k] = *(const u32x4_t*)(H + (t0 + 8 * k + (lane >> 3)) * HP + C_GG + hd * 64 + (lane & 7) * 8);
    {
        const int d = tid >> 4, v4 = (tid & 15) * 4;
        float4 S4 = make_float4(0.f, 0.f, 0.f, 0.f);
#pragma unroll 8
        for (int sp = 0; sp < seg; ++sp) {
            const int it = (item & ~31) + sp;
            const float e = GD[it * 32 + d];
            const float4 sv = *(const float4*)(GS + (size_t)it * 2048 + d * 64 + v4);
            S4.x = e * S4.x + sv.x; S4.y = e * S4.y + sv.y; S4.z = e * S4.z + sv.z; S4.w = e * S4.w + sv.w;
        }
#pragma unroll
        for (int c = 0; c < 8; ++c) {
            bf16_t* ST = (bf16_t*)(sm + GLW + c * GLR) + 64 * 72;
            ST[(v4 + 0) * 40 + d] = f2bf(S4.x); ST[(v4 + 1) * 40 + d] = f2bf(S4.y); ST[(v4 + 2) * 40 + d] = f2bf(S4.z); ST[(v4 + 3) * 40 + d] = f2bf(S4.w);
            const size_t ci = (size_t)bh * 256 + seg * 8 + c;
            const float e = DEC[ci * 32 + d];
            const float4 dv4 = *(const float4*)(DS + ci * 2048 + d * 64 + v4);
            S4.x = e * S4.x + dv4.x; S4.y = e * S4.y + dv4.y; S4.z = e * S4.z + dv4.z; S4.w = e * S4.w + dv4.w;
        }
    }
    __syncthreads();
    bf16_t* attS = (bf16_t*)(sm + GLW + w * GLR);
    const bf16_t* ST = attS + 64 * 72;
#pragma unroll
    for (int mt = 0; mt < 4; ++mt)
#pragma unroll
        for (int nt = 0; nt < 4; ++nt) {
            if (nt <= mt) {
                f32x4_t at = (f32x4_t){0.f, 0.f, 0.f, 0.f};
                at = __builtin_amdgcn_mfma_f32_16x16x32_bf16(aq[mt], bk[nt], at, 0, 0, 0);
#pragma unroll
                for (int rg = 0; rg < 4; ++rg) {
                    float v = at[rg];
                    if (nt == mt && r16 > 4 * g + rg) v = 0.f;
                    attS[(16 * mt + 4 * g + rg) * 72 + 16 * nt + r16] = f2bf(v);
                }
            } else if (nt == mt + 1 && (mt & 1) == 0) {
#pragma unroll
                for (int rg = 0; rg < 4; ++rg) attS[(16 * mt + 4 * g + rg) * 72 + 16 * nt + r16] = (bf16_t)0;
            }
        }
    f32x4_t acc[4][4];
#pragma unroll
    for (int mt = 0; mt < 4; ++mt)
#pragma unroll
        for (int nt = 0; nt < 4; ++nt) acc[mt][nt] = (f32x4_t){0.f, 0.f, 0.f, 0.f};
    bf16x8_t sf[4];
#pragma unroll
    for (int nt = 0; nt < 4; ++nt) sf[nt] = *(const bf16x8_t*)(ST + (16 * nt + r16) * 40 + 8 * g);
#pragma unroll
    for (int mt = 0; mt < 4; ++mt) {
#pragma unroll
        for (int ks = 0; ks < 2; ++ks) {
            if (ks == 0 || mt >= 2) {
                const bf16x8_t af = *(const bf16x8_t*)(attS + (16 * mt + r16) * 72 + 32 * ks + 8 * g);
#pragma unroll
                for (int nt = 0; nt < 4; ++nt) acc[mt][nt] = __builtin_amdgcn_mfma_f32_16x16x32_bf16(af, vf[nt][ks], acc[mt][nt], 0, 0, 0);
            }
        }
#pragma unroll
        for (int nt = 0; nt < 4; ++nt) acc[mt][nt] = __builtin_amdgcn_mfma_f32_16x16x32_bf16(aq[mt], sf[nt], acc[mt][nt], 0, 0, 0);
    }
    float nw[4];
#pragma unroll
    for (int nt = 0; nt < 4; ++nt) nw[nt] = P.gla_norm_w[layer * 64 + 16 * nt + r16];
#pragma unroll
    for (int mt = 0; mt < 4; ++mt)
#pragma unroll
        for (int rg = 0; rg < 4; ++rg) {
            float ss = 0.f;
#pragma unroll
            for (int nt = 0; nt < 4; ++nt) ss += acc[mt][nt][rg] * acc[mt][nt][rg];
            ss += __shfl_xor(ss, 1); ss += __shfl_xor(ss, 2); ss += __shfl_xor(ss, 4); ss += __shfl_xor(ss, 8);
            const float r = rsqrtf(ss * (1.f / 64.f) + 1e-6f);
#pragma unroll
            for (int nt = 0; nt < 4; ++nt) attS[(16 * mt + 4 * g + rg) * 72 + 16 * nt + r16] = f2bf(acc[mt][nt][rg] * r * nw[nt]);
        }
#pragma unroll
    for (int k = 0; k < 8; ++k) {
        const int tk = 8 * k + (lane >> 3);
        const u32x4_t yq = *(const u32x4_t*)(attS + tk * 72 + (lane & 7) * 8);
        const unsigned yw[4] = {yq.x, yq.y, yq.z, yq.w}, gw[4] = {gq[k].x, gq[k].y, gq[k].z, gq[k].w};
        unsigned ow[4];
#pragma unroll
        for (int e = 0; e < 4; ++e) {
            const float g0 = bflo(gw[e]), g1 = bfhi(gw[e]);
            ow[e] = pack2bf(bflo(yw[e]) * (g0 * sigmoid_f(g0)), bfhi(yw[e]) * (g1 * sigmoid_f(g1)));
        }
        u32x4_t oq; oq.x = ow[0]; oq.y = ow[1]; oq.z = ow[2]; oq.w = ow[3];
        *(u32x4_t*)(O + (t0 + tk) * DM + hd * 64 + (lane & 7) * 8) = oq;
    }
    __syncthreads();
}

typedef float f32x16_t __attribute__((ext_vector_type(16)));
typedef unsigned long long u64_t;
__device__ __forceinline__ void swa_item(const Params& P, int layer, float* smem, int item) {
    const int b = item >> 8, n = (item >> 1) & 127, kvh = item & 1;
    const bf16_t* H = (const bf16_t*)(P.ws + WS_H);
    bf16_t* O = (bf16_t*)(P.ws + WS_O);
    const float2* cs = (const float2*)(P.ws + WS_CS);
    bf16_t* Ks = (bf16_t*)smem;
    bf16_t* Vt = Ks + 256 * 72;
    const int tid = otid(P.wv), lane = tid & 63, w = tid >> 6;
    const size_t blk0 = (size_t)b * SEQ + (size_t)n * 128;
    const int jstart = (n == 0) ? 128 : 0;
    const int g = w >> 1, qh = w & 1, head = kvh * 4 + g, ql = lane & 31, h32 = lane >> 5;
    const float sink2 = P.swa_sinks[layer * 8 + head] * 1.4426950408889634f;
    bf16x8_t qfa[2][4];
#pragma unroll
    for (int qt = 0; qt < 2; ++qt) {
        const size_t tq = blk0 + 64 * qh + 32 * qt + ql;
        const bf16_t* qrow = H + tq * HP + C_SQ + head * 64 + 8 * h32;
        float qa[4][8];
#pragma unroll
        for (int ks = 0; ks < 4; ++ks) {
            const u32x4_t w4 = *(const u32x4_t*)(qrow + 16 * ks);
            qa[ks][0] = bflo(w4.x); qa[ks][1] = bfhi(w4.x); qa[ks][2] = bflo(w4.y); qa[ks][3] = bfhi(w4.y);
            qa[ks][4] = bflo(w4.z); qa[ks][5] = bfhi(w4.z); qa[ks][6] = bflo(w4.w); qa[ks][7] = bfhi(w4.w);
        }
        const float SC = 0.125f * 1.4426950408889634f;
#pragma unroll
        for (int ks = 0; ks < 2; ++ks)
#pragma unroll
            for (int j = 0; j < 8; ++j) {
                const float2 c = cs[tq * 32 + 16 * ks + 8 * h32 + j];
                const float q1 = qa[ks][j], q2 = qa[ks + 2][j];
                qa[ks][j] = (q1 * c.x - q2 * c.y) * SC; qa[ks + 2][j] = (q2 * c.x + q1 * c.y) * SC;
            }
#pragma unroll
        for (int ks = 0; ks < 4; ++ks) {
            u32x4_t pk; pk.x = pack2bf(qa[ks][0], qa[ks][1]); pk.y = pack2bf(qa[ks][2], qa[ks][3]); pk.z = pack2bf(qa[ks][4], qa[ks][5]); pk.w = pack2bf(qa[ks][6], qa[ks][7]);
            qfa[qt][ks] = __builtin_bit_cast(bf16x8_t, pk);
        }
    }
#pragma unroll
    for (int it = 0; it < 2; ++it) {
        const int i = tid + it * NTH, j = i >> 2, sg = i & 3;
        u32x4_t o1 = {0u, 0u, 0u, 0u}, o2 = {0u, 0u, 0u, 0u};
        if (j >= jstart) {
            const size_t tk = blk0 - 128 + j;
            const bf16_t* hrow = H + tk * HP + C_SK + kvh * 64 + sg * 8;
            const u32x4_t w1 = *(const u32x4_t*)hrow, w2 = *(const u32x4_t*)(hrow + 32);
            const float4* cp = (const float4*)(cs + tk * 32 + sg * 8);
            const float4 c01 = cp[0], c23 = cp[1], c45 = cp[2], c67 = cp[3];
            const float k1[8] = {bflo(w1.x), bfhi(w1.x), bflo(w1.y), bfhi(w1.y), bflo(w1.z), bfhi(w1.z), bflo(w1.w), bfhi(w1.w)};
            const float k2[8] = {bflo(w2.x), bfhi(w2.x), bflo(w2.y), bfhi(w2.y), bflo(w2.z), bfhi(w2.z), bflo(w2.w), bfhi(w2.w)};
            const float cc[8] = {c01.x, c01.z, c23.x, c23.z, c45.x, c45.z, c67.x, c67.z}, sn[8] = {c01.y, c01.w, c23.y, c23.w, c45.y, c45.w, c67.y, c67.w};
            float r1[8], r2[8];
#pragma unroll
            for (int e = 0; e < 8; ++e) { r1[e] = k1[e] * cc[e] - k2[e] * sn[e]; r2[e] = k2[e] * cc[e] + k1[e] * sn[e]; }
            o1.x = pack2bf(r1[0], r1[1]); o1.y = pack2bf(r1[2], r1[3]); o1.z = pack2bf(r1[4], r1[5]); o1.w = pack2bf(r1[6], r1[7]);
            o2.x = pack2bf(r2[0], r2[1]); o2.y = pack2bf(r2[2], r2[3]); o2.z = pack2bf(r2[4], r2[5]); o2.w = pack2bf(r2[6], r2[7]);
        }
        *(u32x4_t*)(Ks + j * 72 + sg * 8) = o1; *(u32x4_t*)(Ks + j * 72 + 32 + sg * 8) = o2;
    }
    for (int i = tid; i < 256 * 16; i += NTH) {
        const int j = i >> 4, d4 = i & 15;
        u32x2_t wv = {0u, 0u};
        if (j >= jstart) wv = *(const u32x2_t*)(H + (blk0 - 128 + j) * HP + C_SV + kvh * 64 + d4 * 4);
        Vt[(d4 * 4 + 0) * 260 + j] = (bf16_t)(wv.x & 0xffffu); Vt[(d4 * 4 + 1) * 260 + j] = (bf16_t)(wv.x >> 16);
        Vt[(d4 * 4 + 2) * 260 + j] = (bf16_t)(wv.y & 0xffffu); Vt[(d4 * 4 + 3) * 260 + j] = (bf16_t)(wv.y >> 16);
    }
    __syncthreads();
#pragma unroll 1
    for (int qt = 0; qt < 2; ++qt) {
        const int qi = 64 * qh + 32 * qt + ql;
        const size_t tq = blk0 + qi;
        bf16x8_t qf[4];
#pragma unroll
        for (int ks = 0; ks < 4; ++ks) qf[ks] = qt ? qfa[1][ks] : qfa[0][ks];
        f32x16_t st[5];
#pragma unroll
        for (int t5 = 0; t5 < 5; ++t5) {
            st[t5] = (f32x16_t){0.f, 0.f, 0.f, 0.f, 0.f, 0.f, 0.f, 0.f, 0.f, 0.f, 0.f, 0.f, 0.f, 0.f, 0.f, 0.f};
            const bf16_t* kp = Ks + (64 * qh + 32 * (qt + t5) + ql) * 72 + 8 * h32;
#pragma unroll
            for (int ks = 0; ks < 4; ++ks) {
                const bf16x8_t kf = *(const bf16x8_t*)(kp + 16 * ks);
                st[t5] = __builtin_amdgcn_mfma_f32_32x32x16_bf16(kf, qf[ks], st[t5], 0, 0, 0);
            }
        }
        const int dl = 4 * h32 - ql;
        float mx = -INFINITY;
#pragma unroll
        for (int r = 0; r < 16; ++r) {
            const int off = (r & 3) + 8 * (r >> 2);
            st[0][r] = (off + dl >= 1) ? st[0][r] : -INFINITY;
            st[4][r] = (off + dl <= 0) ? st[4][r] : -INFINITY;
        }
        if (n == 0) {
#pragma unroll
            for (int t5 = 0; t5 < 5; ++t5)
#pragma unroll
                for (int r = 0; r < 16; ++r) {
                    const int kj = 64 * qh + 32 * (qt + t5) + (r & 3) + 8 * (r >> 2) + 4 * h32;
                    st[t5][r] = (kj >= 128) ? st[t5][r] : -INFINITY;
                }
        }
#pragma unroll
        for (int t5 = 0; t5 < 5; ++t5)
#pragma unroll
            for (int r = 0; r < 16; ++r) mx = fmaxf(mx, st[t5][r]);
        mx = fmaxf(mx, __shfl_xor(mx, 32));
        const float m = fmaxf(mx, sink2);
        float l = 0.f;
#pragma unroll
        for (int t5 = 0; t5 < 5; ++t5)
#pragma unroll
            for (int r = 0; r < 16; ++r) { const float pj = __builtin_amdgcn_exp2f(st[t5][r] - m); st[t5][r] = pj; l += pj; }
        l += __shfl_xor(l, 32);
        l += __builtin_amdgcn_exp2f(sink2 - m);
        f32x16_t ot[2];
        ot[0] = (f32x16_t){0.f, 0.f, 0.f, 0.f, 0.f, 0.f, 0.f, 0.f, 0.f, 0.f, 0.f, 0.f, 0.f, 0.f, 0.f, 0.f}; ot[1] = ot[0];
#pragma unroll
        for (int t5 = 0; t5 < 5; ++t5)
#pragma unroll
            for (int sx = 0; sx < 2; ++sx) {
                u32x4_t pk; pk.x = pack2bf(st[t5][8 * sx + 0], st[t5][8 * sx + 1]); pk.y = pack2bf(st[t5][8 * sx + 2], st[t5][8 * sx + 3]);
                pk.z = pack2bf(st[t5][8 * sx + 4], st[t5][8 * sx + 5]); pk.w = pack2bf(st[t5][8 * sx + 6], st[t5][8 * sx + 7]);
                const bf16x8_t pf = __builtin_bit_cast(bf16x8_t, pk);
                const int kb = 64 * qh + 32 * (qt + t5) + 16 * sx + 4 * h32;
#pragma unroll
                for (int dt = 0; dt < 2; ++dt) {
                    const bf16_t* vp = Vt + (32 * dt + ql) * 260 + kb;
                    const u64_t v0 = *(const u64_t*)vp, v1 = *(const u64_t*)(vp + 8);
                    u32x4_t vk; vk.x = (unsigned)v0; vk.y = (unsigned)(v0 >> 32); vk.z = (unsigned)v1; vk.w = (unsigned)(v1 >> 32);
                    ot[dt] = __builtin_amdgcn_mfma_f32_32x32x16_bf16(__builtin_bit_cast(bf16x8_t, vk), pf, ot[dt], 0, 0, 0);
                }
            }
        const float inv = 1.f / l;
        bf16_t* orow = O + tq * DM + 256 + head * 64 + 4 * h32;
#pragma unroll
        for (int dt = 0; dt < 2; ++dt)
#pragma unroll
            for (int r4 = 0; r4 < 4; ++r4) {
                u32x2_t ov; ov.x = pack2bf(ot[dt][4 * r4 + 0] * inv, ot[dt][4 * r4 + 1] * inv); ov.y = pack2bf(ot[dt][4 * r4 + 2] * inv, ot[dt][4 * r4 + 3] * inv);
                *(u32x2_t*)(orow + 32 * dt + 8 * r4) = ov;
            }
    }
    __syncthreads();
}

__device__ __forceinline__ void lru1_item(const Params& P, int layer, float* smem, int item) {
    const int b = item >> 7, ch = item & 127;
    const bf16_t* H = (const bf16_t*)(P.ws + WS_H);
    unsigned* LAU = (unsigned*)(P.ws + WS_LA);
    float* AGP = (float*)(P.ws + WS_AGP);
    float* AGH = (float*)(P.ws + WS_AGH);
    bf16_t* Xs = (bf16_t*)smem;
    const int tid = otid(P.wv);
    const size_t t0 = (size_t)b * SEQ + (size_t)ch * 128;
    const int lane = tid & 63, w = tid >> 6, blk = w >> 1, th = w & 1, r16 = lane & 15, g = lane >> 4;
    bf16x8_t wf[2][4][2];
    {
        const bf16_t* wb = (const bf16_t*)(P.ws + WS_WLRU) + ((size_t)(layer * 2) * 4 + blk) * 4096 + r16 * 64 + 8 * g;
#pragma unroll
        for (int gt = 0; gt < 2; ++gt)
#pragma unroll
            for (int nt = 0; nt < 4; ++nt)
#pragma unroll
                for (int ks = 0; ks < 2; ++ks) wf[gt][nt][ks] = *(const bf16x8_t*)(wb + (size_t)gt * 4 * 4096 + nt * 16 * 64 + ks * 32);
    }
    float br[4], bi[4], lsl[4];
#pragma unroll
    for (int nt = 0; nt < 4; ++nt) {
        const int c = blk * 64 + 16 * nt + r16;
        br[nt] = P.lru_b_r[layer * 256 + c]; bi[nt] = P.lru_b_i[layer * 256 + c];
        lsl[nt] = 8.f * log_sigmoid_f(P.lru_lambda[layer * 256 + c]);
    }
    {
        const int cg = tid & 31, tq = tid >> 5;
        const float* cw = P.lru_conv_w + layer * 4 * 256 + cg * 8;
        float wc[4][8], bb[8];
#pragma unroll
        for (int d = 0; d < 4; ++d) {
            const float4 a = *(const float4*)(cw + d * 256), c4 = *(const float4*)(cw + d * 256 + 4);
            wc[d][0] = a.x; wc[d][1] = a.y; wc[d][2] = a.z; wc[d][3] = a.w; wc[d][4] = c4.x; wc[d][5] = c4.y; wc[d][6] = c4.z; wc[d][7] = c4.w;
        }
        { const float4 a = *(const float4*)(P.lru_conv_b + layer * 256 + cg * 8), c4 = *(const float4*)(P.lru_conv_b + layer * 256 + cg * 8 + 4);
          bb[0] = a.x; bb[1] = a.y; bb[2] = a.z; bb[3] = a.w; bb[4] = c4.x; bb[5] = c4.y; bb[6] = c4.z; bb[7] = c4.w; }
#pragma unroll 4
        for (int k = 0; k < 8; ++k) {
            const int tt = tq + 16 * k, tloc = ch * 128 + tt;
            const bf16_t* hp = H + (t0 + tt) * HP + C_RR + cg * 8;
            const u32x4_t z4 = {0u, 0u, 0u, 0u};
            u32x4_t rr[4];
            rr[3] = *(const u32x4_t*)hp;
            rr[2] = (tloc >= 1) ? *(const u32x4_t*)(hp - 1 * HP) : z4;
            rr[1] = (tloc >= 2) ? *(const u32x4_t*)(hp - 2 * HP) : z4;
            rr[0] = (tloc >= 3) ? *(const u32x4_t*)(hp - 3 * HP) : z4;
            float o[8];
#pragma unroll
            for (int e = 0; e < 8; ++e) o[e] = bb[e];
#pragma unroll
            for (int d = 0; d < 4; ++d) {
                const float xv[8] = {bflo(rr[d].x), bfhi(rr[d].x), bflo(rr[d].y), bfhi(rr[d].y), bflo(rr[d].z), bfhi(rr[d].z), bflo(rr[d].w), bfhi(rr[d].w)};
#pragma unroll
                for (int e = 0; e < 8; ++e) o[e] += wc[d][e] * xv[e];
            }
            u32x4_t pk; pk.x = pack2bf(o[0], o[1]); pk.y = pack2bf(o[2], o[3]); pk.z = pack2bf(o[4], o[5]); pk.w = pack2bf(o[6], o[7]);
            *(u32x4_t*)(Xs + tt * 264 + cg * 8) = pk;
        }
    }
    __syncthreads();
    float Pw[4], Hw[4];
#pragma unroll
    for (int nt = 0; nt < 4; ++nt) { Pw[nt] = 1.f; Hw[nt] = 0.f; }
#pragma unroll 1
    for (int mt = 0; mt < 4; ++mt) {
        const int trow = th * 64 + 16 * mt;
        f32x4_t ar[4], ai[4];
#pragma unroll
        for (int nt = 0; nt < 4; ++nt) { ar[nt] = (f32x4_t){0.f, 0.f, 0.f, 0.f}; ai[nt] = ar[nt]; }
#pragma unroll
        for (int ks = 0; ks < 2; ++ks) {
            const bf16x8_t af = *(const bf16x8_t*)(Xs + (trow + r16) * 264 + blk * 64 + 32 * ks + 8 * g);
#pragma unroll
            for (int nt = 0; nt < 4; ++nt) {
                ar[nt] = __builtin_amdgcn_mfma_f32_16x16x32_bf16(af, wf[0][nt][ks], ar[nt], 0, 0, 0);
                ai[nt] = __builtin_amdgcn_mfma_f32_16x16x32_bf16(af, wf[1][nt][ks], ai[nt], 0, 0, 0);
            }
        }
        float Pl[4], Hl[4];
#pragma unroll
        for (int nt = 0; nt < 4; ++nt) { Pl[nt] = 1.f; Hl[nt] = 0.f; }
#pragma unroll
        for (int rg = 0; rg < 4; ++rg) {
            const int tt = trow + 4 * g + rg;
            const size_t t = t0 + tt;
#pragma unroll
            for (int nt = 0; nt < 4; ++nt) {
                const int c = blk * 64 + 16 * nt + r16;
                const float r = sigmoid_f(ar[nt][rg] + br[nt]), ig = sigmoid_f(ai[nt][rg] + bi[nt]);
                const h2x_t lu = __builtin_amdgcn_cvt_pkrtz(lsl[nt] * r * 1.4426950408889634f, 0.f);
                const float la2 = (float)lu[0];
                const float av = __builtin_amdgcn_exp2f(la2);
                const float uf = __builtin_amdgcn_sqrtf(fmaxf(1.f - av * av, 0.f)) * (ig * bf2f(Xs[tt * 264 + c]));
                const h2x_t up = __builtin_amdgcn_cvt_pkrtz(la2, uf);
                const float uv = (float)up[1];
                LAU[t * 256 + c] = __builtin_bit_cast(unsigned, up);
                Pl[nt] *= av; Hl[nt] = av * Hl[nt] + uv;
            }
        }
#pragma unroll
        for (int nt = 0; nt < 4; ++nt) {
            float Pp = __shfl_xor(Pl[nt], 16), Hp = __shfl_xor(Hl[nt], 16);
            if (g & 1) { Hl[nt] = Pl[nt] * Hp + Hl[nt]; } else { Hl[nt] = Pp * Hl[nt] + Hp; }
            Pl[nt] *= Pp;
            Pp = __shfl_xor(Pl[nt], 32); Hp = __shfl_xor(Hl[nt], 32);
            if (g & 2) { Hl[nt] = Pl[nt] * Hp + Hl[nt]; } else { Hl[nt] = Pp * Hl[nt] + Hp; }
            Pl[nt] *= Pp;
            Hw[nt] = Pl[nt] * Hw[nt] + Hl[nt]; Pw[nt] *= Pl[nt];
        }
    }
    if (g == 0) {
#pragma unroll
        for (int nt = 0; nt < 4; ++nt) {
            const int c = blk * 64 + 16 * nt + r16;
            AGP[((size_t)b * 256 + ch * 2 + th) * 256 + c] = Pw[nt];
            AGH[((size_t)b * 256 + ch * 2 + th) * 256 + c] = Hw[nt];
        }
    }
    __syncthreads();
}

__device__ __forceinline__ void lru2_item(const Params& P, int layer, float* smem, int item) {
    const int b = item >> 7, ch = item & 127;
    const bf16_t* H = (const bf16_t*)(P.ws + WS_H);
    const unsigned* LAU = (const unsigned*)(P.ws + WS_LA);
    const float* AGP = (const float*)(P.ws + WS_AGP);
    const float* AGH = (const float*)(P.ws + WS_AGH);
    bf16_t* O = (bf16_t*)(P.ws + WS_O);
    const int tid = otid(P.wv), lane = tid & 63, w = tid >> 6;
    const size_t t0 = (size_t)b * SEQ + (size_t)ch * 128 + 16 * w;
    u32x4_t lau[16]; u32x2_t rgv[16];
#pragma unroll
    for (int i = 0; i < 16; ++i) {
        lau[i] = *(const u32x4_t*)(LAU + (t0 + i) * 256 + lane * 4);
        rgv[i] = *(const u32x2_t*)(H + (t0 + i) * HP + C_RG + lane * 4);
    }
    const int nsub = ch * 2;
    {
        const int per = (nsub + 7) >> 3, s0 = w * per, s1 = (s0 + per < nsub) ? s0 + per : nsub;
        float4 Pm = make_float4(1.f, 1.f, 1.f, 1.f), Hm = make_float4(0.f, 0.f, 0.f, 0.f);
#pragma unroll 8
        for (int sidx = s0; sidx < s1; ++sidx) {
            const float4 p4 = *(const float4*)(AGP + ((size_t)b * 256 + sidx) * 256 + lane * 4), h4 = *(const float4*)(AGH + ((size_t)b * 256 + sidx) * 256 + lane * 4);
            Hm.x = p4.x * Hm.x + h4.x; Hm.y = p4.y * Hm.y + h4.y; Hm.z = p4.z * Hm.z + h4.z; Hm.w = p4.w * Hm.w + h4.w;
            Pm.x *= p4.x; Pm.y *= p4.y; Pm.z *= p4.z; Pm.w *= p4.w;
        }
        *(float4*)(smem + (w * 2 + 0) * 256 + lane * 4) = Pm; *(float4*)(smem + (w * 2 + 1) * 256 + lane * 4) = Hm;
    }
    {
        float Pl[4] = {1.f, 1.f, 1.f, 1.f}, Hl[4] = {0.f, 0.f, 0.f, 0.f};
#pragma unroll
        for (int i = 0; i < 16; ++i)
#pragma unroll
            for (int j = 0; j < 4; ++j) {
                const unsigned q = lau[i][j];
                const h2x_t p = __builtin_bit_cast(h2x_t, q);
                const float a = __builtin_amdgcn_exp2f((float)p[0]);
                Hl[j] = a * Hl[j] + (float)p[1]; Pl[j] *= a;
            }
        *(float4*)(smem + 4096 + (w * 2 + 0) * 256 + lane * 4) = make_float4(Pl[0], Pl[1], Pl[2], Pl[3]);
        *(float4*)(smem + 4096 + (w * 2 + 1) * 256 + lane * 4) = make_float4(Hl[0], Hl[1], Hl[2], Hl[3]);
    }
    __syncthreads();
    float h[4] = {0.f, 0.f, 0.f, 0.f};
#pragma unroll
    for (int k = 0; k < 8; ++k) {
        const float4 p4 = *(const float4*)(smem + (k * 2 + 0) * 256 + lane * 4), h4 = *(const float4*)(smem + (k * 2 + 1) * 256 + lane * 4);
        h[0] = p4.x * h[0] + h4.x; h[1] = p4.y * h[1] + h4.y; h[2] = p4.z * h[2] + h4.z; h[3] = p4.w * h[3] + h4.w;
    }
    for (int k = 0; k < w; ++k) {
        const float4 p4 = *(const float4*)(smem + 4096 + (k * 2 + 0) * 256 + lane * 4), h4 = *(const float4*)(smem + 4096 + (k * 2 + 1) * 256 + lane * 4);
        h[0] = p4.x * h[0] + h4.x; h[1] = p4.y * h[1] + h4.y; h[2] = p4.z * h[2] + h4.z; h[3] = p4.w * h[3] + h4.w;
    }
#pragma unroll
    for (int i = 0; i < 16; ++i) {
        float o[4];
        const float rg[4] = {bflo(rgv[i].x), bfhi(rgv[i].x), bflo(rgv[i].y), bfhi(rgv[i].y)};
#pragma unroll
        for (int j = 0; j < 4; ++j) {
            const unsigned q = lau[i][j];
                const h2x_t p = __builtin_bit_cast(h2x_t, q);
            h[j] = __builtin_amdgcn_exp2f((float)p[0]) * h[j] + (float)p[1];
            o[j] = gelu_tanh_f(rg[j]) * h[j];
        }
        u32x2_t ov; ov.x = pack2bf(o[0], o[1]); ov.y = pack2bf(o[2], o[3]);
        *(u32x2_t*)(O + (t0 + i) * DM + 768 + lane * 4) = ov;
    }
    __syncthreads();
}

template <bool F32RES>
__device__ __forceinline__ void phase_ln1(const Params& P, int layer) {
    const bf16_t* xinb = (const bf16_t*)P.out;
    const bf16_t* X1R = (const bf16_t*)(P.ws + WS_X1R);
    bf16_t* X1B = (bf16_t*)(P.ws + WS_X1B);
    const float* g = P.ln1_g + layer * DM; const float* bt = P.ln1_b + layer * DM;
    const int tid = otid(P.wv), wave = tid >> 6, lane = tid & 63;
    const int rstep = gridDim.x * 8;
    int row = blockIdx.x * 8 + wave;
    if (row >= T) return;
    u32x2_t a0, a1, a2, a3, m0, m1, m2, m3;
#define LN_LD_(r_) do { const size_t ix_ = (size_t)(r_) * DM + lane * 4; \
        a0 = *(const u32x2_t*)(xinb + ix_); a1 = *(const u32x2_t*)(xinb + ix_ + 256); a2 = *(const u32x2_t*)(xinb + ix_ + 512); a3 = *(const u32x2_t*)(xinb + ix_ + 768); \
        m0 = *(const u32x2_t*)(X1R + ix_); m1 = *(const u32x2_t*)(X1R + ix_ + 256); m2 = *(const u32x2_t*)(X1R + ix_ + 512); m3 = *(const u32x2_t*)(X1R + ix_ + 768); } while (0)
#define LN_V_(a_, m_) make_float4(DN_ALPHA * bflo((a_).x) + bflo((m_).x), DN_ALPHA * bfhi((a_).x) + bfhi((m_).x), DN_ALPHA * bflo((a_).y) + bflo((m_).y), DN_ALPHA * bfhi((a_).y) + bfhi((m_).y))
    LN_LD_(row);
    for (;;) {
        float4 v[4]; float s = 0.f;
        v[0] = LN_V_(a0, m0); v[1] = LN_V_(a1, m1); v[2] = LN_V_(a2, m2); v[3] = LN_V_(a3, m3);
        const int nrow = row + rstep;
        const bool more = nrow < T;
        LN_LD_(more ? nrow : row);
#pragma unroll
        for (int j = 0; j < 4; ++j) s += (v[j].x + v[j].y) + (v[j].z + v[j].w);
        const float mean = wave_sum(s) * (1.f / DM);
        float s2 = 0.f;
#pragma unroll
        for (int j = 0; j < 4; ++j) {
            v[j].x -= mean; v[j].y -= mean; v[j].z -= mean; v[j].w -= mean;
            s2 += (v[j].x * v[j].x + v[j].y * v[j].y) + (v[j].z * v[j].z + v[j].w * v[j].w);
        }
        const float rstd = rsqrtf(wave_sum(s2) * (1.f / DM) + 1e-5f);
#pragma unroll
        for (int j = 0; j < 4; ++j) {
            const int col = j * 256 + lane * 4;
            const float4 gg = *(const float4*)(g + col), bb = *(const float4*)(bt + col);
            u32x2_t w;
            w.x = pack2bf(v[j].x * rstd * gg.x + bb.x, v[j].y * rstd * gg.y + bb.y);
            w.y = pack2bf(v[j].z * rstd * gg.z + bb.z, v[j].w * rstd * gg.w + bb.w);
            *(u32x2_t*)(X1B + (size_t)row * DM + col) = w;
        }
        if (!more) break;
        row = nrow;
    }
#undef LN_LD_
#undef LN_V_
}

#define KEY_INSERT(tv, key) do { float cv_ = (key); \
    _Pragma("unroll") for (int j_ = 0; j_ < 16; ++j_) { const float hi_ = __builtin_fmaxf(tv[j_], cv_); cv_ = __builtin_fminf(tv[j_], cv_); tv[j_] = hi_; } } while (0)

#define CE_(x, y) do { const float h_ = __builtin_fmaxf(x, y); y = __builtin_fminf(x, y); x = h_; } while (0)
#define SORT16(A) do { CE_(A[0], A[13]); CE_(A[1], A[12]); CE_(A[2], A[15]); CE_(A[3], A[14]); CE_(A[4], A[8]); CE_(A[5], A[6]); CE_(A[7], A[11]); CE_(A[9], A[10]); CE_(A[0], A[5]); CE_(A[1], A[7]); CE_(A[2], A[9]); CE_(A[3], A[4]); CE_(A[6], A[13]); CE_(A[8], A[14]); CE_(A[10], A[15]); CE_(A[11], A[12]); CE_(A[0], A[1]); CE_(A[2], A[3]); CE_(A[4], A[5]); CE_(A[6], A[8]); CE_(A[7], A[9]); CE_(A[10], A[11]); CE_(A[12], A[13]); CE_(A[14], A[15]); CE_(A[0], A[2]); CE_(A[1], A[3]); CE_(A[4], A[10]); CE_(A[5], A[11]); CE_(A[6], A[7]); CE_(A[8], A[9]); CE_(A[12], A[14]); CE_(A[13], A[15]); CE_(A[1], A[2]); CE_(A[3], A[12]); CE_(A[4], A[6]); CE_(A[5], A[7]); CE_(A[8], A[10]); CE_(A[9], A[11]); CE_(A[13], A[14]); CE_(A[1], A[4]); CE_(A[2], A[6]); CE_(A[5], A[8]); CE_(A[7], A[10]); CE_(A[9], A[13]); CE_(A[11], A[14]); CE_(A[2], A[4]); CE_(A[3], A[6]); CE_(A[9], A[12]); CE_(A[11], A[13]); CE_(A[3], A[5]); CE_(A[6], A[8]); CE_(A[7], A[9]); CE_(A[10], A[12]); CE_(A[3], A[4]); CE_(A[5], A[6]); CE_(A[7], A[8]); CE_(A[9], A[10]); CE_(A[11], A[12]); CE_(A[6], A[7]); CE_(A[8], A[9]); } while (0)
#define TOP16_MERGE(A, B) do { CE_(A[0], B[15]); CE_(A[1], B[14]); CE_(A[2], B[13]); CE_(A[3], B[12]); CE_(A[4], B[11]); CE_(A[5], B[10]); CE_(A[6], B[9]); CE_(A[7], B[8]); CE_(A[8], B[7]); CE_(A[9], B[6]); CE_(A[10], B[5]); CE_(A[11], B[4]); CE_(A[12], B[3]); CE_(A[13], B[2]); CE_(A[14], B[1]); CE_(A[15], B[0]); CE_(A[0], A[8]); CE_(A[1], A[9]); CE_(A[2], A[10]); CE_(A[3], A[11]); CE_(A[4], A[12]); CE_(A[5], A[13]); CE_(A[6], A[14]); CE_(A[7], A[15]); CE_(A[0], A[4]); CE_(A[1], A[5]); CE_(A[2], A[6]); CE_(A[3], A[7]); CE_(A[8], A[12]); CE_(A[9], A[13]); CE_(A[10], A[14]); CE_(A[11], A[15]); CE_(A[0], A[2]); CE_(A[1], A[3]); CE_(A[4], A[6]); CE_(A[5], A[7]); CE_(A[8], A[10]); CE_(A[9], A[11]); CE_(A[12], A[14]); CE_(A[13], A[15]); CE_(A[0], A[1]); CE_(A[2], A[3]); CE_(A[4], A[5]); CE_(A[6], A[7]); CE_(A[8], A[9]); CE_(A[10], A[11]); CE_(A[12], A[13]); CE_(A[14], A[15]); } while (0)

constexpr int TK_SC = 17408;
constexpr int TK_LST = TK_SC;
constexpr int TK_ITL = TK_SC + 2 * 4 * 128 * 20;
template <bool OWN>
__device__ __forceinline__ void phase_topk(const Params& P, int layer, float* smem) {
    const bf16_t* Q = (const bf16_t*)(P.ws + WS_Q);
    int* EXP = (int*)(P.ws + WS_EXP);
    float* GAT = (float*)(P.ws + WS_GAT);
    const int tid = otid(P.wv), lane = tid & 63, w = tid >> 6, r16 = lane & 15, g = lane >> 4, row = tid & 127, qtr = tid >> 7;
    bf16_t* kl = (bf16_t*)smem;
    float* LST = smem + TK_LST;
    int* itl = (int*)(smem + TK_ITL);
    {
        if (tid < 64) {
            int key = -1;
            if (OWN) { pg8::StaticOrder S; S.init(T, 3072, (int)gridDim.x, (int)blockIdx.x); pg8::Unit un; if (S.next(tid, un) && un.pn < 8) key = (un.pn << 16) | un.pm; }
            else { const int item = (int)blockIdx.x + tid * (int)gridDim.x; if (item < 1024) key = ((item & 7) << 16) | (item >> 3); }
            itl[tid] = key;
        }
        __syncthreads();
        if (tid < 64) {
            const int key = itl[tid]; int rank = 0, cnt = 0;
            for (int e = 0; e < 64; ++e) { const int ke = itl[e]; if (ke >= 0) { ++cnt; if (ke < key) ++rank; } }
            if (key >= 0) itl[64 + rank] = key;
            if (tid == 0) itl[128] = cnt;
        }
        __syncthreads();
    }
    const int nit = itl[128];
    const int nu = 2 * nit;
    if (nu <= 0) return;
    const size_t qoff = (size_t)(16 * w + r16) * 2048 + 8 * g;
    const unsigned g4 = 4u * (unsigned)g;
    const bool godd = (g & 1) != 0;
    bf16x8_t aq[2][4];
    {
        const int key = itl[64], h = key >> 16;
        const size_t tok0 = (size_t)(key & 0xffff) * 256;
#pragma unroll
        for (int c = 0; c < 2; ++c)
#pragma unroll
            for (int ks = 0; ks < 4; ++ks) aq[c][ks] = *(const bf16x8_t*)(Q + tok0 * 2048 + qoff + h * 256 + c * 128 + 32 * ks);
    }
    int hcur = -1;
#pragma unroll 1
    for (int u = 0; u < nu; ++u) {
        const int k = u >> 1, key = itl[64 + k], h = key >> 16, tile = key & 0xffff, st = u & 1;
        if (h != hcur) {
            const u32x4_t* src = (const u32x4_t*)((const bf16_t*)(P.ws + WS_SKB) + ((size_t)layer * 8 + h) * 32768);
            for (int i = tid; i < 4096; i += NTH) { const u32x4_t v = src[i]; *(u32x4_t*)(kl + (i >> 4) * 136 + (i & 15) * 8) = v; }
            __syncthreads();
            hcur = h;
        }
        float L0[16], L1[16];
#pragma unroll
        for (int c = 0; c < 2; ++c) {
            f32x4_t acc[8];
#pragma unroll
            for (int nt = 0; nt < 8; ++nt) acc[nt] = (f32x4_t){0.f, 0.f, 0.f, 0.f};
#pragma unroll
            for (int ks = 0; ks < 4; ++ks)
#pragma unroll
                for (int nt = 0; nt < 8; ++nt) {
                    const bf16x8_t kfr = *(const bf16x8_t*)(kl + (c * 128 + 16 * nt + r16) * 136 + 32 * ks + 8 * g);
                    acc[nt] = __builtin_amdgcn_mfma_f32_16x16x32_bf16(kfr, aq[c][ks], acc[nt], 0, 0, 0);
                }
            if (c == 1 && u + 1 < nu) {
                const int nkey = itl[64 + ((u + 1) >> 1)], nh = nkey >> 16;
                const size_t ntok0 = (size_t)(nkey & 0xffff) * 256 + ((u + 1) & 1) * 128;
#pragma unroll
                for (int c2 = 0; c2 < 2; ++c2)
#pragma unroll
                    for (int ks = 0; ks < 4; ++ks) aq[c2][ks] = *(const bf16x8_t*)(Q + ntok0 * 2048 + qoff + nh * 256 + c2 * 128 + 32 * ks);
            }
            float x[32];
#pragma unroll
            for (int nt = 0; nt < 8; ++nt)
#pragma unroll
                for (int rg = 0; rg < 4; ++rg) x[nt * 4 + rg] = __uint_as_float(((__float_as_uint(acc[nt][rg]) & ~127u) | g4) | (unsigned)(16 * nt + rg));
            SORT16(x); SORT16((x + 16)); TOP16_MERGE(x, (x + 16));
#pragma unroll
            for (int j = 0; j < 16; ++j) { if (c == 0) L0[j] = x[j]; else L1[j] = x[j]; }
        }
        float M[16], R[16];
#pragma unroll
        for (int j = 0; j < 16; ++j) { const float snd = godd ? L0[j] : L1[j]; R[j] = __shfl_xor(snd, 16); M[j] = godd ? L1[j] : L0[j]; }
        TOP16_MERGE(M, R);
#pragma unroll
        for (int j = 0; j < 16; ++j) R[j] = __shfl_xor(M[j], 32);
        TOP16_MERGE(M, R);
        float* lst = LST + (k & 1) * (4 * 128 * 20);
        if (g < 2) {
            float* pd = lst + ((st * 2 + g) * 128 + 16 * w + r16) * 20;
#pragma unroll
            for (int j4 = 0; j4 < 4; ++j4) *(float4*)(pd + j4 * 4) = make_float4(M[j4 * 4], M[j4 * 4 + 1], M[j4 * 4 + 2], M[j4 * 4 + 3]);
        }
        if (st == 1) {
            __syncthreads();
            if (tid < 256) {
                const float* x0 = lst + ((qtr * 2 + 0) * 128 + row) * 20;
                const float* x1 = lst + ((qtr * 2 + 1) * 128 + row) * 20;
#pragma unroll
                for (int j4 = 0; j4 < 4; ++j4) {
                    const float4 va = *(const float4*)(x0 + j4 * 4), vb = *(const float4*)(x1 + j4 * 4);
                    L0[j4 * 4] = va.x; L0[j4 * 4 + 1] = va.y; L0[j4 * 4 + 2] = va.z; L0[j4 * 4 + 3] = va.w;
                    L1[j4 * 4] = vb.x; L1[j4 * 4 + 1] = vb.y; L1[j4 * 4 + 2] = vb.z; L1[j4 * 4 + 3] = vb.w;
                }
                float s1[16];
#pragma unroll
                for (int j = 0; j < 16; ++j) s1[j] = __uint_as_float(__float_as_uint(L1[j]) & ~127u);
#define CKEY_(a2, bb) __uint_as_float((__float_as_uint(__uint_as_float(__float_as_uint(L0[a2]) & ~127u) + s1[bb]) & ~255u) | (unsigned)((a2) * 16 + (bb)))
                float bv[16], c1[16], c2[16], c3[16];
#pragma unroll
                for (int j = 0; j < 16; ++j) { bv[j] = CKEY_(0, j); c1[j] = (j < 8) ? CKEY_(1, j) : -INFINITY; }
                c2[0] = CKEY_(2, 0); c2[1] = CKEY_(2, 1); c2[2] = CKEY_(2, 2); c2[3] = CKEY_(2, 3); c2[4] = CKEY_(2, 4);
                c2[5] = CKEY_(3, 0); c2[6] = CKEY_(3, 1); c2[7] = CKEY_(3, 2); c2[8] = CKEY_(3, 3);
                c2[9] = CKEY_(4, 0); c2[10] = CKEY_(4, 1); c2[11] = CKEY_(4, 2);
                c2[12] = -INFINITY; c2[13] = -INFINITY; c2[14] = -INFINITY; c2[15] = -INFINITY;
                c3[0] = CKEY_(5, 0); c3[1] = CKEY_(5, 1); c3[2] = CKEY_(6, 0); c3[3] = CKEY_(6, 1); c3[4] = CKEY_(7, 0); c3[5] = CKEY_(7, 1);
                c3[6] = CKEY_(8, 0); c3[7] = CKEY_(9, 0); c3[8] = CKEY_(10, 0); c3[9] = CKEY_(11, 0); c3[10] = CKEY_(12, 0); c3[11] = CKEY_(13, 0); c3[12] = CKEY_(14, 0); c3[13] = CKEY_(15, 0);
                c3[14] = -INFINITY; c3[15] = -INFINITY;
#undef CKEY_
                TOP16_MERGE(bv, c1);
                SORT16(c2); TOP16_MERGE(bv, c2);
                SORT16(c3); TOP16_MERGE(bv, c3);
                float lg[16]; int ex[16];
#pragma unroll
                for (int j = 0; j < 16; ++j) {
                    const unsigned pr = __float_as_uint(bv[j]) & 255u;
                    const unsigned k0 = __float_as_uint(x0[pr >> 4]), k1 = __float_as_uint(x1[pr & 15]);
                    lg[j] = __uint_as_float(k0 & ~127u) + __uint_as_float(k1 & ~127u);
                    ex[j] = (int)((k0 & 127u) * 128u + (k1 & 127u));
                }
                float mx = lg[0];
#pragma unroll
                for (int j = 1; j < 16; ++j) mx = fmaxf(mx, lg[j]);
                float e[16], sum = 0.f;
#pragma unroll
                for (int j = 0; j < 16; ++j) { e[j] = fast_exp(lg[j] - mx); sum += e[j]; }
                const float inv = 1.f / sum;
                const size_t t = (size_t)tile * 256 + qtr * 128 + row;
                int4* eo = (int4*)(EXP + t * 128 + h * 16);
                float4* go = (float4*)(GAT + t * 128 + h * 16);
#pragma unroll
                for (int j4 = 0; j4 < 4; ++j4) {
                    eo[j4] = make_int4(ex[j4 * 4], ex[j4 * 4 + 1], ex[j4 * 4 + 2], ex[j4 * 4 + 3]);
                    go[j4] = make_float4(e[j4 * 4] * inv, e[j4 * 4 + 1] * inv, e[j4 * 4 + 2] * inv, e[j4 * 4 + 3] * inv);
                }
            }
        }
    }
    __syncthreads();
}

typedef float f32x2_t __attribute__((ext_vector_type(2)));
#define FP8_UNPACK16(q, f) do { f32x2_t p_; \
    p_ = __builtin_amdgcn_cvt_pk_f32_fp8((int)(q).x, false); f[0] = p_.x; f[1] = p_.y; p_ = __builtin_amdgcn_cvt_pk_f32_fp8((int)(q).x, true); f[2] = p_.x; f[3] = p_.y; \
    p_ = __builtin_amdgcn_cvt_pk_f32_fp8((int)(q).y, false); f[4] = p_.x; f[5] = p_.y; p_ = __builtin_amdgcn_cvt_pk_f32_fp8((int)(q).y, true); f[6] = p_.x; f[7] = p_.y; \
    p_ = __builtin_amdgcn_cvt_pk_f32_fp8((int)(q).z, false); f[8] = p_.x; f[9] = p_.y; p_ = __builtin_amdgcn_cvt_pk_f32_fp8((int)(q).z, true); f[10] = p_.x; f[11] = p_.y; \
    p_ = __builtin_amdgcn_cvt_pk_f32_fp8((int)(q).w, false); f[12] = p_.x; f[13] = p_.y; p_ = __builtin_amdgcn_cvt_pk_f32_fp8((int)(q).w, true); f[14] = p_.x; f[15] = p_.y; } while (0)
__device__ __forceinline__ void phase_peer_eval(const Params& P, int layer) {
    const bf16_t* X1B = (const bf16_t*)(P.ws + WS_X1B);
    const bf16_t* E = (const bf16_t*)(P.ws + WS_PE);
    const int* EXP = (const int*)(P.ws + WS_EXP);
    const float* GAT = (const float*)(P.ws + WS_GAT);
    const unsigned char* UB = (const unsigned char*)(P.ws + WS_UB);
    const unsigned char* VB = (const unsigned char*)(P.ws + WS_VB);
    bf16_t* XB = (bf16_t*)(P.ws + WS_XB);
    float* OUT = P.out;
    const float* g = P.ln2_g + layer * DM; const float* bt = P.ln2_b + layer * DM;
    const int tid = otid(P.wv), wave = tid >> 6, lane = tid & 63;
    const bool hi32 = (lane & 32) != 0, b16 = (lane & 16) != 0, b8 = (lane & 8) != 0;
    const int kk = 4 * (lane >> 5) + 2 * ((lane >> 4) & 1) + ((lane >> 3) & 1);
    for (int tok = blockIdx.x * 8 + wave; tok < T; tok += gridDim.x * 8) {
        float xv[16], yv[16];
#pragma unroll
        for (int j = 0; j < 2; ++j) {
            const u32x4_t w = *(const u32x4_t*)(X1B + (size_t)tok * DM + lane * 16 + j * 8);
            xv[j * 8 + 0] = bflo(w.x); xv[j * 8 + 1] = bfhi(w.x); xv[j * 8 + 2] = bflo(w.y); xv[j * 8 + 3] = bfhi(w.y);
            xv[j * 8 + 4] = bflo(w.z); xv[j * 8 + 5] = bfhi(w.z); xv[j * 8 + 6] = bflo(w.w); xv[j * 8 + 7] = bfhi(w.w);
        }
#pragma unroll
        for (int i = 0; i < 16; ++i) yv[i] = 0.f;
        const int e_lo = EXP[(size_t)tok * 128 + lane], e_hi = EXP[(size_t)tok * 128 + 64 + lane];
        const float g_lo = GAT[(size_t)tok * 128 + lane], g_hi = GAT[(size_t)tok * 128 + 64 + lane];
#pragma unroll 2
        for (int gi = 0; gi < 16; ++gi) {
            const int esel = (gi < 8) ? e_lo : e_hi;
            const float gsel = (gi < 8) ? g_lo : g_hi;
            const int l0 = (gi & 7) * 8;
            u32x4_t uq[8], vq[8];
#pragma unroll
            for (int k = 0; k < 8; ++k) {
                const int ex = __builtin_amdgcn_readlane(esel, l0 + k);
                uq[k] = *(const u32x4_t*)(UB + (size_t)ex * DM + lane * 16);
                vq[k] = *(const u32x4_t*)(VB + (size_t)ex * DM + lane * 16);
            }
            float d[8];
#pragma unroll
            for (int k = 0; k < 8; ++k) {
                float f[16]; FP8_UNPACK16(uq[k], f);
                float acc = 0.f;
#pragma unroll
                for (int i = 0; i < 16; ++i) acc += f[i] * xv[i];
                d[k] = acc;
            }
            float r4[4], r2[2];
#pragma unroll
            for (int k = 0; k < 4; ++k) { const float send = hi32 ? d[k] : d[k + 4]; const float keep = hi32 ? d[k + 4] : d[k]; r4[k] = keep + __shfl_xor(send, 32); }
#pragma unroll
            for (int k = 0; k < 2; ++k) { const float send = b16 ? r4[k] : r4[k + 2]; const float keep = b16 ? r4[k + 2] : r4[k]; r2[k] = keep + __shfl_xor(send, 16); }
            float tsum;
            { const float send = b8 ? r2[0] : r2[1]; const float keep = b8 ? r2[1] : r2[0]; tsum = keep + __shfl_xor(send, 8); }
            tsum += __shfl_xor(tsum, 4); tsum += __shfl_xor(tsum, 2); tsum += __shfl_xor(tsum, 1);
            const float gt = __shfl(gsel, l0 + kk);
            const float hvl = gelu_tanh_f(tsum * (1.f / FP8_SU)) * gt * (1.f / FP8_SV);
#pragma unroll
            for (int k = 0; k < 8; ++k) {
                const float hv = __uint_as_float((unsigned)__builtin_amdgcn_readlane((int)__float_as_uint(hvl), 32 * (k >> 2) + 16 * ((k >> 1) & 1) + 8 * (k & 1)));
                float f[16]; FP8_UNPACK16(vq[k], f);
#pragma unroll
                for (int i = 0; i < 16; ++i) yv[i] += hv * f[i];
            }
        }
        float s = 0.f;
#pragma unroll
        for (int j = 0; j < 2; ++j) {
            const u32x4_t w = *(const u32x4_t*)(E + (size_t)tok * DM + lane * 16 + j * 8);
            const float ev[8] = {bflo(w.x), bfhi(w.x), bflo(w.y), bfhi(w.y), bflo(w.z), bfhi(w.z), bflo(w.w), bfhi(w.w)};
#pragma unroll
            for (int i = 0; i < 8; ++i) { yv[j * 8 + i] = DN_ALPHA * xv[j * 8 + i] + yv[j * 8 + i] + ev[i]; s += yv[j * 8 + i]; }
        }
        const float mean = wave_sum(s) * (1.f / DM);
        float s2 = 0.f;
#pragma unroll
        for (int i = 0; i < 16; ++i) { yv[i] -= mean; s2 += yv[i] * yv[i]; }
        const float rstd = rsqrtf(wave_sum(s2) * (1.f / DM) + 1e-5f);
        float ov[16];
#pragma unroll
        for (int j = 0; j < 4; ++j) {
            const int col = lane * 16 + j * 4;
            const float4 gg = *(const float4*)(g + col), bb = *(const float4*)(bt + col);
            ov[j * 4 + 0] = yv[j * 4 + 0] * rstd * gg.x + bb.x; ov[j * 4 + 1] = yv[j * 4 + 1] * rstd * gg.y + bb.y;
            ov[j * 4 + 2] = yv[j * 4 + 2] * rstd * gg.z + bb.z; ov[j * 4 + 3] = yv[j * 4 + 3] * rstd * gg.w + bb.w;
            *(float4*)(OUT + (size_t)tok * DM + col) = make_float4(ov[j * 4 + 0], ov[j * 4 + 1], ov[j * 4 + 2], ov[j * 4 + 3]);
        }
#pragma unroll
        for (int j = 0; j < 2; ++j) {
            u32x4_t w; w.x = pack2bf(ov[j * 8 + 0], ov[j * 8 + 1]); w.y = pack2bf(ov[j * 8 + 2], ov[j * 8 + 3]); w.z = pack2bf(ov[j * 8 + 4], ov[j * 8 + 5]); w.w = pack2bf(ov[j * 8 + 6], ov[j * 8 + 7]);
            *(u32x4_t*)(XB + (size_t)tok * DM + lane * 16 + j * 8) = w;
        }
    }
}

constexpr float FP4_SU = 64.f, FP4_SV = 4.f;
__device__ __forceinline__ void convert_fp4(const float* __restrict__ src, unsigned char* __restrict__ dst, size_t n, float scale, int gtid, int gnth) {
    size_t i = (size_t)gtid * 32;
    if (i >= n) return;
    f32x4_t r0, r1, r2, r3, r4, r5, r6, r7;
#define CV_LD_(p) do { r0 = *(const f32x4_t*)(p); r1 = *(const f32x4_t*)((p) + 4); r2 = *(const f32x4_t*)((p) + 8); r3 = *(const f32x4_t*)((p) + 12); \
                       r4 = *(const f32x4_t*)((p) + 16); r5 = *(const f32x4_t*)((p) + 20); r6 = *(const f32x4_t*)((p) + 24); r7 = *(const f32x4_t*)((p) + 28); } while (0)
#define CV_PK_(a, b) ({ unsigned v_ = 0; \
        v_ = __builtin_amdgcn_cvt_scalef32_pk_fp4_f32(v_, (a)[0] * scale, (a)[1] * scale, 1.0f, 0); v_ = __builtin_amdgcn_cvt_scalef32_pk_fp4_f32(v_, (a)[2] * scale, (a)[3] * scale, 1.0f, 1); \
        v_ = __builtin_amdgcn_cvt_scalef32_pk_fp4_f32(v_, (b)[0] * scale, (b)[1] * scale, 1.0f, 2); v_ = __builtin_amdgcn_cvt_scalef32_pk_fp4_f32(v_, (b)[2] * scale, (b)[3] * scale, 1.0f, 3); v_; })
    CV_LD_(src + i);
    for (;;) {
        const size_t in = i + (size_t)gnth * 32;
        const bool more = in < n;
        u32x4_t w;
        w.x = CV_PK_(r0, r1); w.y = CV_PK_(r2, r3); w.z = CV_PK_(r4, r5); w.w = CV_PK_(r6, r7);
        const float* spn = src + (more ? in : i);
        CV_LD_(spn);
        *(u32x4_t*)(dst + (i >> 1)) = w;
        if (!more) break;
        i = in;
    }
#undef CV_LD_
#undef CV_PK_
}
__device__ __forceinline__ void convert_fp4_perm(const float* __restrict__ src, unsigned char* __restrict__ dst, size_t n, float scale, const unsigned char* __restrict__ PI, float* smem, int wv) {
    const int tid = otid(wv), wave = tid >> 6, lane = tid & 63, wi = lane >> 2, q = lane & 3;
    float* wl = smem + wave * (16 * 132);
    unsigned off[32];
    {
        const u32x4_t p0 = *(const u32x4_t*)(PI + 32 * q), p1 = *(const u32x4_t*)(PI + 32 * q + 16);
        const unsigned pw[8] = {p0.x, p0.y, p0.z, p0.w, p1.x, p1.y, p1.z, p1.w};
#pragma unroll
        for (int j = 0; j < 32; ++j) off[j] = (unsigned)wi * 132u + ((pw[j >> 2] >> (8 * (j & 3))) & 255u);
    }
    const int nchunks = (int)(n >> 11);
    int c = blockIdx.x * 8 + wave;
    if (c >= nchunks) return;
    f32x4_t r0, r1, r2, r3, r4, r5, r6, r7;
#define CU_LD_(p) do { r0 = *(const f32x4_t*)((p) + lane * 4); r1 = *(const f32x4_t*)((p) + 256 + lane * 4); r2 = *(const f32x4_t*)((p) + 512 + lane * 4); r3 = *(const f32x4_t*)((p) + 768 + lane * 4); \
                       r4 = *(const f32x4_t*)((p) + 1024 + lane * 4); r5 = *(const f32x4_t*)((p) + 1280 + lane * 4); r6 = *(const f32x4_t*)((p) + 1536 + lane * 4); r7 = *(const f32x4_t*)((p) + 1792 + lane * 4); } while (0)
#define CU_ST_(i_, r_) do { const int p_ = ((i_) * 64 + lane) * 4; *(f32x4_t*)(wl + (p_ >> 7) * 132 + (p_ & 127)) = r_; } while (0)
    CU_LD_(src + (size_t)c * 2048);
    for (;; ) {
        CU_ST_(0, r0); CU_ST_(1, r1); CU_ST_(2, r2); CU_ST_(3, r3); CU_ST_(4, r4); CU_ST_(5, r5); CU_ST_(6, r6); CU_ST_(7, r7);
        const int cn = c + gridDim.x * 8;
        const bool more = cn < nchunks;
        const float* spn = src + (size_t)(more ? cn : c) * 2048;
        CU_LD_(spn);
        u32x4_t w;
#pragma unroll
        for (int j = 0; j < 4; ++j) {
            float f[8];
#pragma unroll
            for (int e = 0; e < 8; ++e) f[e] = wl[off[j * 8 + e]] * scale;
            unsigned v = 0;
            v = __builtin_amdgcn_cvt_scalef32_pk_fp4_f32(v, f[0], f[1], 1.0f, 0);
            v = __builtin_amdgcn_cvt_scalef32_pk_fp4_f32(v, f[2], f[3], 1.0f, 1);
            v = __builtin_amdgcn_cvt_scalef32_pk_fp4_f32(v, f[4], f[5], 1.0f, 2);
            v = __builtin_amdgcn_cvt_scalef32_pk_fp4_f32(v, f[6], f[7], 1.0f, 3);
            w[j] = v;
        }
        *(u32x4_t*)(dst + (size_t)c * 1024 + lane * 16) = w;
        if (!more) break;
        c = cn;
    }
#undef CU_LD_
#undef CU_ST_
}
#define FP4_UNPACK16(q, f) do { f32x2_t p_; \
    p_ = __builtin_amdgcn_cvt_scalef32_pk_f32_fp4((q).x, 1.0f, 0); f[0] = p_.x; f[1] = p_.y; p_ = __builtin_amdgcn_cvt_scalef32_pk_f32_fp4((q).x, 1.0f, 1); f[2] = p_.x; f[3] = p_.y; \
    p_ = __builtin_amdgcn_cvt_scalef32_pk_f32_fp4((q).x, 1.0f, 2); f[4] = p_.x; f[5] = p_.y; p_ = __builtin_amdgcn_cvt_scalef32_pk_f32_fp4((q).x, 1.0f, 3); f[6] = p_.x; f[7] = p_.y; \
    p_ = __builtin_amdgcn_cvt_scalef32_pk_f32_fp4((q).y, 1.0f, 0); f[8] = p_.x; f[9] = p_.y; p_ = __builtin_amdgcn_cvt_scalef32_pk_f32_fp4((q).y, 1.0f, 1); f[10] = p_.x; f[11] = p_.y; \
    p_ = __builtin_amdgcn_cvt_scalef32_pk_f32_fp4((q).y, 1.0f, 2); f[12] = p_.x; f[13] = p_.y; p_ = __builtin_amdgcn_cvt_scalef32_pk_f32_fp4((q).y, 1.0f, 3); f[14] = p_.x; f[15] = p_.y; } while (0)
typedef __attribute__((address_space(3))) unsigned lds_u32_t;
typedef _Float16 h2_t __attribute__((ext_vector_type(2)));
constexpr int EVW = 4416;
#define EV_DMA(ESEL, gsub) do { const int l0_ = (gsub) * 16; \
    _Pragma("unroll") for (int k = 0; k < 8; ++k) { \
        const int ea_ = __builtin_amdgcn_readlane(ESEL, l0_ + 2 * k), eb_ = __builtin_amdgcn_readlane(ESEL, l0_ + 2 * k + 1); \
        const unsigned off_ = (unsigned)(hi32 ? eb_ : ea_) * 512u + (unsigned)(lane & 31) * 16u; \
        __builtin_amdgcn_global_load_lds((const unsigned*)(UB + off_), (lds_u32_t*)(wl + k * 1056), 16, 0, 0); \
        __builtin_amdgcn_global_load_lds((const unsigned*)(VB + off_), (lds_u32_t*)(wl + 8448 + k * 1024), 16, 0, 0); } } while (0)
template <bool LASTL>
__device__ __forceinline__ void phase_peer_eval_fp4(const Params& P, int layer, float* smem) {
    const bf16_t* X1B = (const bf16_t*)(P.ws + WS_X1B);
    const bf16_t* E = (const bf16_t*)(P.ws + WS_PE);
    const int* EXP = (const int*)(P.ws + WS_EXP);
    const float* GAT = (const float*)(P.ws + WS_GAT);
    const unsigned char* UB = (const unsigned char*)(P.ws + WS_UB);
    const unsigned char* VB = (const unsigned char*)(P.ws + WS_VB);
    bf16_t* XB = (bf16_t*)P.out;
    float* OUT = P.out;
    const int tid = otid(P.wv), wave = __builtin_amdgcn_readfirstlane(tid >> 6), lane = tid & 63;
    {
        const float* g = P.ln2_g + layer * DM; const float* bt = P.ln2_b + layer * DM;
        for (int i = tid; i < DM; i += NTH) { smem[i] = g[i]; smem[DM + i] = bt[i]; }
        __syncthreads();
    }
    const float* gl = smem + lane * 16;
    char* wl = (char*)(smem + 2 * DM + wave * EVW);
    const unsigned lo16 = (unsigned)lane * 32u, lo8 = (unsigned)lane * 8u;
    const bool hi32 = (lane & 32) != 0;
    const int r16 = lane & 15, kb = lane >> 4;
    const char* ua = wl + (r16 >> 1) * 1056 + (r16 & 1) * 512 + kb * 16;
    const char* xb8 = wl + 16640 + kb * 32;
    const bool xswap = ((unsigned)__builtin_amdgcn_cvt_pk_fp8_f32(1.0f, 2.0f, 0, false) & 0xFFu) != 0x38u;
    const int tstride = gridDim.x * 8;
    int tok = blockIdx.x * 8 + wave;
    if (tok < T) {
    int e_lo, e_hi; float g_lo, g_hi; u32x4_t xp0, xp1;
    {
        const char* idrow = (const char*)uniform_ptr(EXP + (size_t)tok * 128);
        const char* gtrow = (const char*)uniform_ptr(GAT + (size_t)tok * 128);
        const char* xrow = (const char*)uniform_ptr(X1B + (size_t)tok * DM);
        e_lo = *(const int*)(idrow + lane * 4u); e_hi = *(const int*)(idrow + 256 + lane * 4u);
        g_lo = *(const float*)(gtrow + lane * 4u); g_hi = *(const float*)(gtrow + 256 + lane * 4u);
        xp0 = *(const u32x4_t*)(xrow + lo16); xp1 = *(const u32x4_t*)(xrow + lo16 + 16);
    }
    EV_DMA(e_lo, 0);
#pragma unroll 1
    for (; tok < T; tok += tstride) {
        const int ntok = tok + tstride;
        const bool more = ntok < T;
        float yv[16];
        float xf[16];
        {
            const unsigned xw[8] = {xp0.x, xp0.y, xp0.z, xp0.w, xp1.x, xp1.y, xp1.z, xp1.w};
#pragma unroll
            for (int i = 0; i < 8; ++i) { xf[2 * i] = bflo(xw[i]); xf[2 * i + 1] = bfhi(xw[i]); }
            u32x4_t x8;
#pragma unroll
            for (int q = 0; q < 4; ++q) {
                const float a0 = xswap ? xf[4 * q + 1] : xf[4 * q], a1 = xswap ? xf[4 * q] : xf[4 * q + 1];
                const float a2 = xswap ? xf[4 * q + 3] : xf[4 * q + 2], a3 = xswap ? xf[4 * q + 2] : xf[4 * q + 3];
                int v = 0;
                v = __builtin_amdgcn_cvt_pk_fp8_f32(a0, a1, v, false);
                v = __builtin_amdgcn_cvt_pk_fp8_f32(a2, a3, v, true);
                x8[q] = (unsigned)v;
            }
            *(u32x4_t*)(wl + 16640 + lane * 16) = x8;
        }
#pragma unroll
        for (int i = 0; i < 16; ++i) yv[i] = 0.f;
        int ne_lo = 0, ne_hi = 0; float ng_lo = 0.f, ng_hi = 0.f;
        if (more) {
            const char* idrow = (const char*)uniform_ptr(EXP + (size_t)ntok * 128);
            const char* gtrow = (const char*)uniform_ptr(GAT + (size_t)ntok * 128);
            const char* xrow = (const char*)uniform_ptr(X1B + (size_t)ntok * DM);
            ne_lo = *(const int*)(idrow + lane * 4u); ne_hi = *(const int*)(idrow + 256 + lane * 4u);
            ng_lo = *(const float*)(gtrow + lane * 4u); ng_hi = *(const float*)(gtrow + 256 + lane * 4u);
            xp0 = *(const u32x4_t*)(xrow + lo16); xp1 = *(const u32x4_t*)(xrow + lo16 + 16);
        }
#pragma unroll 1
        for (int gi = 0; gi < 8; ++gi) {
            const float gsel = (gi < 4) ? g_lo : g_hi;
            const int l0 = (gi & 3) * 16;
            asm volatile("s_waitcnt vmcnt(0)" ::: "memory");
            u32x2_t vq[16];
#pragma unroll
            for (int k = 0; k < 16; ++k) vq[k] = *(const u32x2_t*)(wl + 8448 + k * 512 + lo8);
            u32x4_t af[8];
#pragma unroll
            for (int ks = 0; ks < 8; ++ks) af[ks] = *(const u32x4_t*)(ua + ks * 64);
            asm volatile("s_waitcnt lgkmcnt(0)" ::: "memory");
            if (gi < 3) { EV_DMA(e_lo, gi + 1); } else if (gi < 7) { EV_DMA(e_hi, gi - 3); } else if (more) { EV_DMA(ne_lo, 0); }
            f32x4_t dacc = (f32x4_t){0.f, 0.f, 0.f, 0.f};
#pragma unroll
            for (int ks = 0; ks < 8; ++ks) {
                const u32x4_t b0 = *(const u32x4_t*)(xb8 + ks * 128), b1 = *(const u32x4_t*)(xb8 + ks * 128 + 16);
                const v8i_t av = {(int)af[ks].x, (int)af[ks].y, (int)af[ks].z, (int)af[ks].w, 0, 0, 0, 0};
                const v8i_t bv = {(int)b0.x, (int)b0.y, (int)b0.z, (int)b0.w, (int)b1.x, (int)b1.y, (int)b1.z, (int)b1.w};
                dacc = __builtin_amdgcn_mfma_scale_f32_16x16x128_f8f6f4(av, bv, dacc, 4, 0, 0, 0x7F7F7F7F, 0, 0x7F7F7F7F);
            }
            float hv4[4];
#pragma unroll
            for (int rg = 0; rg < 4; ++rg) {
                const float gt = __shfl(gsel, l0 + 4 * kb + rg);
                hv4[rg] = gelu_tanh_f(dacc[rg] * (1.f / FP4_SU)) * gt * (1.f / FP4_SV);
            }
#pragma unroll
            for (int k = 0; k < 16; ++k) {
                const float hv = __uint_as_float((unsigned)__builtin_amdgcn_readlane((int)__float_as_uint(hv4[k & 3]), 16 * (k >> 2)));
                float f[16]; FP4_UNPACK16(vq[k], f);
#pragma unroll
                for (int i = 0; i < 16; ++i) yv[i] += hv * f[i];
            }
        }
        const char* erow = (const char*)uniform_ptr(E + (size_t)tok * DM);
        char* orow = (char*)uniform_ptr(OUT + (size_t)tok * DM);
        char* xbrow = (char*)uniform_ptr(XB + (size_t)tok * DM);
        float s = 0.f;
#pragma unroll
        for (int j = 0; j < 2; ++j) {
            const u32x4_t w = *(const u32x4_t*)(erow + lo16 + j * 16);
            const float ev[8] = {bflo(w.x), bfhi(w.x), bflo(w.y), bfhi(w.y), bflo(w.z), bfhi(w.z), bflo(w.w), bfhi(w.w)};
#pragma unroll
            for (int i = 0; i < 8; ++i) { yv[j * 8 + i] = DN_ALPHA * xf[j * 8 + i] + yv[j * 8 + i] + ev[i]; s += yv[j * 8 + i]; }
        }
        const float mean = wave_sum(s) * (1.f / DM);
        float s2 = 0.f;
#pragma unroll
        for (int i = 0; i < 16; ++i) { yv[i] -= mean; s2 += yv[i] * yv[i]; }
        const float rstd = rsqrtf(wave_sum(s2) * (1.f / DM) + 1e-5f);
        float ov[16];
#pragma unroll
        for (int j = 0; j < 4; ++j) {
            const float4 gg = *(const float4*)(gl + j * 4), bb = *(const float4*)(gl + DM + j * 4);
            ov[j * 4 + 0] = yv[j * 4 + 0] * rstd * gg.x + bb.x; ov[j * 4 + 1] = yv[j * 4 + 1] * rstd * gg.y + bb.y;
            ov[j * 4 + 2] = yv[j * 4 + 2] * rstd * gg.z + bb.z; ov[j * 4 + 3] = yv[j * 4 + 3] * rstd * gg.w + bb.w;
            if (LASTL) *(float4*)(orow + lane * 64u + j * 16) = make_float4(ov[j * 4 + 0], ov[j * 4 + 1], ov[j * 4 + 2], ov[j * 4 + 3]);
        }
        if (!LASTL) {
#pragma unroll
        for (int j = 0; j < 2; ++j) {
            u32x4_t w; w.x = pack2bf(ov[j * 8 + 0], ov[j * 8 + 1]); w.y = pack2bf(ov[j * 8 + 2], ov[j * 8 + 3]); w.z = pack2bf(ov[j * 8 + 4], ov[j * 8 + 5]); w.w = pack2bf(ov[j * 8 + 6], ov[j * 8 + 7]);
            *(u32x4_t*)(xbrow + lo16 + j * 16) = w;
        }
        }
        e_lo = ne_lo; e_hi = ne_hi; g_lo = ng_lo; g_hi = ng_hi;
    }
    }
    asm volatile("s_waitcnt vmcnt(0)" ::: "memory");
}

template <int PH>
__device__ __forceinline__ void run_phase(const Params& P, int layer, float* smem) {
    if constexpr (PH == 0) phase_prologue(P, smem);
    if constexpr (PH == 1) {
        pg8::EpiBf16P E{(bf16_t*)(P.ws + WS_H), HP};
        run_gemm(smem, (const bf16_t*)P.out, (const bf16_t*)(P.ws + WS_WIN) + (size_t)layer * HP * DM, T, HP, DM, E, P.wv);
        for (int it = blockIdx.x; it < T / 128; it += gridDim.x) alow_item(P, layer, it);
        const int tid = otid(P.wv), gtid = blockIdx.x * NTH + tid, gnth = gridDim.x * NTH;
#if PEER_FP4
        __syncthreads();
        convert_fp4_perm(P.peer_u + (size_t)layer * 16384 * DM, (unsigned char*)(P.ws + WS_UB), (size_t)16384 * DM, FP4_SU, (const unsigned char*)(P.ws + WS_PI), smem, P.wv);
        convert_fp4(P.peer_v + (size_t)layer * 16384 * DM, (unsigned char*)(P.ws + WS_VB), (size_t)16384 * DM, FP4_SV, gtid, gnth);
#else
        convert_fp8(P.peer_u + (size_t)layer * 16384 * DM, (unsigned char*)(P.ws + WS_UB), (size_t)16384 * DM, FP8_SU, gtid, gnth);
        convert_fp8(P.peer_v + (size_t)layer * 16384 * DM, (unsigned char*)(P.ws + WS_VB), (size_t)16384 * DM, FP8_SV, gtid, gnth);
#endif
    }
    if constexpr (PH == 2) {
        for (int it = blockIdx.x; it < 1024; it += gridDim.x) {
            if (it < 512) { swa_item(P, layer, smem, it); if (REPEAT_SUB & 1) swa_item(P, layer, smem, it); }
            else if (it < 768) { gla_pre_item(P, layer, smem, it - 512); if (REPEAT_SUB & 2) gla_pre_item(P, layer, smem, it - 512); }
            else { lru1_item(P, layer, smem, it - 768); if (REPEAT_SUB & 4) lru1_item(P, layer, smem, it - 768); }
        }
        const int tid = otid(P.wv), gtid = blockIdx.x * NTH + tid, gnth = gridDim.x * NTH;
        convert_bf16(P.p + (size_t)layer * T * 256, (bf16_t*)(P.ws + WS_PB), (size_t)T * 256, gtid, gnth);
    }
    if constexpr (PH == 3) for (int it = blockIdx.x; it < 512; it += gridDim.x) {
        if (it < 256) { gla_out_item(P, layer, smem, it); if (REPEAT_SUB & 8) gla_out_item(P, layer, smem, it); }
        else { lru2_item(P, layer, smem, it - 256); if (REPEAT_SUB & 16) lru2_item(P, layer, smem, it - 256); }
    }
    if constexpr (PH == 4) {
        pg8::EpiBf16P E1{(bf16_t*)(P.ws + WS_X1R), DM};
        run_gemm(smem, (const bf16_t*)(P.ws + WS_O), (const bf16_t*)(P.ws + WS_WOUT) + (size_t)layer * DM * DM, T, DM, DM, E1, P.wv);
        pg8::EpiBf16P E2{(bf16_t*)(P.ws + WS_PE), DM};
        run_gemm(smem, (const bf16_t*)(P.ws + WS_PB), (const bf16_t*)(P.ws + WS_WPJ) + (size_t)layer * DM * 256, T, DM, 256, E2, P.wv);
    }
        if constexpr (PH == 5) phase_ln1<false>(P, layer);
    if constexpr (PH == 6) {
        pg8::EpiQG E{(bf16_t*)(P.ws + WS_Q), (bf16_t*)(P.ws + WS_PE)};
        run_gemm(smem, (const bf16_t*)(P.ws + WS_X1B), (const bf16_t*)(P.ws + WS_WQG) + (size_t)layer * 3072 * DM, T, 3072, DM, E, P.wv);
#if FUSED
        phase_topk<true>(P, layer, smem);
#endif
    }
    if constexpr (PH == 7) phase_topk<false>(P, layer, smem);
#if PEER_FP4
    if constexpr (PH == 8) { if (layer == 0) phase_peer_eval_fp4<false>(P, layer, smem); else phase_peer_eval_fp4<true>(P, layer, smem); }
#else
    if constexpr (PH == 8) phase_peer_eval(P, layer);
#endif
}
constexpr int NPH = 8;

#define XB_TMO      128
#define XB_XCNT(j)  (256  + 64 * (j))
#define XB_XSUB(j)  (1280 + 64 * (j))
#define XB_XGEN(j)  (2304 + 64 * (j))
#define XB_TOP      3328
#define XB_TOPGEN   3392
#define XCD_BAR_WORDS 3456
#define XB_SPIN_CAP (1u << 22)

__device__ __forceinline__ unsigned xb_ld(unsigned* p)              { return __hip_atomic_load(p, __ATOMIC_RELAXED, __HIP_MEMORY_SCOPE_AGENT); }
__device__ __forceinline__ unsigned xb_add(unsigned* p, unsigned v) { return __hip_atomic_fetch_add(p, v, __ATOMIC_RELAXED, __HIP_MEMORY_SCOPE_AGENT); }
__device__ __forceinline__ unsigned xb_xcc_id() { return (unsigned)__builtin_amdgcn_s_getreg((3 << 11) | 20) & 0xFu; }
#define XB_SPIN(cond, bar) do { unsigned _sp = 0; while (cond) { __builtin_amdgcn_s_sleep(1); \
    if ((++_sp & 255u) == 0u) { if (xb_ld(&(bar)[XB_TMO])) break; if (_sp > XB_SPIN_CAP) { atomicAdd(&(bar)[XB_TMO], 1u); break; } } } } while (0)

struct XcdBarrier {
    unsigned* bar; unsigned x;
    volatile __attribute__((address_space(3))) unsigned* st;
};

__device__ __forceinline__ XcdBarrier xcd_barrier_post(unsigned* bar, volatile __attribute__((address_space(3))) unsigned* st) {
    XcdBarrier b; b.bar = bar; b.x = xb_xcc_id(); b.st = st;
    if (threadIdx.x == 0) (void)xb_add(&bar[XB_XCNT(b.x)], 1u);
    return b;
}
__device__ __forceinline__ void xcd_barrier_complete(unsigned* bar, unsigned x, unsigned& nloc, unsigned& nx) {
    const unsigned G = gridDim.x * gridDim.y * gridDim.z;
    unsigned sum, cnt, mine, sp = 0u;
    for (;;) {
        sum = 0u; cnt = 0u; mine = 0u;
#pragma unroll
        for (unsigned j = 0; j < 16; ++j) { const unsigned c = xb_ld(&bar[XB_XCNT(j)]); sum += c; cnt += (c > 0u) ? 1u : 0u; mine = (j == x) ? c : mine; }
        if (sum == G) break;
        __builtin_amdgcn_s_sleep(1);
        if ((++sp & 255u) == 0u) { if (xb_ld(&bar[XB_TMO])) break; if (sp > XB_SPIN_CAP) { atomicAdd(&bar[XB_TMO], 1u); break; } }
    }
    nloc = mine > 0u ? mine : 1u; nx = cnt > 0u ? cnt : 1u;
}

__device__ __forceinline__ void xcd_barrier(const XcdBarrier& b) {
    asm volatile("s_waitcnt vmcnt(0)" ::: "memory");
    __syncthreads();
    if (threadIdx.x == 0) {
        unsigned* bar = b.bar;
        __builtin_amdgcn_s_waitcnt(0);
        unsigned nloc = b.st[0], nx = b.st[1];
        if (nloc == 0u) { xcd_barrier_complete(bar, b.x, nloc, nx); b.st[0] = nloc; b.st[1] = nx; }
        const unsigned old = xb_add(&bar[XB_XSUB(b.x)], 1u);
        const unsigned gen = old / nloc;
        if (old + 1u == (gen + 1u) * nloc) {
            __builtin_amdgcn_fence(__ATOMIC_RELEASE, "agent");
            asm volatile("s_waitcnt vmcnt(0)" ::: "memory");
            const unsigned og = xb_add(&bar[XB_TOP], 1u);
            const unsigned tg = og / nx;
            if (og + 1u == (tg + 1u) * nx) xb_add(&bar[XB_TOPGEN], 1u);
            else XB_SPIN(xb_ld(&bar[XB_TOPGEN]) == tg, bar);
            __builtin_amdgcn_fence(__ATOMIC_ACQUIRE, "agent");
            xb_add(&bar[XB_XGEN(b.x)], 1u);
            asm volatile("s_waitcnt vmcnt(0)" ::: "memory");
        } else {
            XB_SPIN(xb_ld(&bar[XB_XGEN(b.x)]) == gen, bar);
            __builtin_amdgcn_fence(__ATOMIC_ACQUIRE, "agent");
            asm volatile("s_waitcnt vmcnt(0)" ::: "memory");
        }
    }
    __syncthreads();
}

#if !FUSED
template <int PH>
__global__ void __launch_bounds__(NTH, 2) phase_kernel(Params P, int layer) {
    extern __shared__ __attribute__((aligned(16))) float smem[];
    P.wv = __builtin_amdgcn_readfirstlane((int)(threadIdx.x >> 6));
    run_phase<PH>(P, layer, smem);
}
#else
__device__ __forceinline__ Params load_params(const Params* lp, int wv) {
    Params q; q.wv = wv; q.pad_ = 0;
#define LP_(f) q.f = (decltype(q.f))uniform_ptr((const void*)lp->f)
    LP_(x); LP_(p); LP_(pos); LP_(w_in); LP_(gla_w_a2); LP_(gla_b_a); LP_(gla_norm_w); LP_(swa_sinks); LP_(lru_conv_w); LP_(lru_conv_b); LP_(lru_w_r);
    LP_(lru_b_r); LP_(lru_w_i); LP_(lru_b_i); LP_(lru_lambda); LP_(w_out); LP_(ln1_g); LP_(ln1_b); LP_(peer_w_q); LP_(peer_sub_keys); LP_(peer_u);
    LP_(peer_v); LP_(ple_w_gate); LP_(ple_w_proj); LP_(ln2_g); LP_(ln2_b); LP_(out); LP_(ws);
#undef LP_
    return q;
}
__global__ void __launch_bounds__(NTH, 2) mega_kernel(Params Pk) {
    extern __shared__ __attribute__((aligned(16))) float smem_all[];
    cg::grid_group grid = cg::this_grid();
    Params* lp = (Params*)smem_all;
    float* smem = smem_all + 64;
    const int wv0 = __builtin_amdgcn_readfirstlane((int)(threadIdx.x >> 6));
    volatile __attribute__((address_space(3))) unsigned* bst = (volatile __attribute__((address_space(3))) unsigned*)smem_all + 60;
    if (blockIdx.x == 0) { unsigned* barw = (unsigned*)(Pk.ws + WS_BAR); for (int i = threadIdx.x; i < XCD_BAR_WORDS; i += NTH) barw[i] = 0u; }
    if (threadIdx.x == 0) { *lp = Pk; bst[0] = 0u; bst[1] = 0u; }
    __syncthreads();
    { const Params P = load_params(lp, wv0); run_phase<0>(P, 0, smem); }
    grid.sync();
    (void)xcd_barrier_post((unsigned*)uniform_ptr(lp->ws + WS_BAR), bst);
#define MK_BARRIER() do { XcdBarrier xb; xb.bar = (unsigned*)uniform_ptr(lp->ws + WS_BAR); xb.x = xb_xcc_id(); xb.st = bst; xcd_barrier(xb); } while (0)
#define MK_STEP(PH, LAYER, LAST) do { \
        { const Params P = load_params(lp, wv0); run_phase<PH>(P, LAYER, smem); } \
        if ((REPEAT_MASK >> PH) & 1) { MK_BARRIER(); { const Params P = load_params(lp, wv0); run_phase<PH>(P, LAYER, smem); } } \
        if (!(LAST)) MK_BARRIER(); } while (0)
    MK_STEP(1, 0, false); MK_STEP(2, 0, false); MK_STEP(3, 0, false); MK_STEP(4, 0, false); MK_STEP(5, 0, false); MK_STEP(6, 0, false); MK_STEP(8, 0, false);
    MK_STEP(1, 1, false); MK_STEP(2, 1, false); MK_STEP(3, 1, false); MK_STEP(4, 1, false); MK_STEP(5, 1, false); MK_STEP(6, 1, false); MK_STEP(8, 1, true);
#undef MK_STEP
#undef MK_BARRIER
}
#endif

#if !FUSED
template <int PH>
static void launch_phase(const Params& P, int layer, int grid, hipStream_t stream) {
    static bool attr_set = false;
    if (!attr_set) { (void)hipFuncSetAttribute((const void*)phase_kernel<PH>, hipFuncAttributeMaxDynamicSharedMemorySize, LDS_BYTES); attr_set = true; }
    hipLaunchKernelGGL(phase_kernel<PH>, dim3(grid), dim3(NTH), LDS_BYTES, stream, P, layer);
}
#endif

extern "C" void kernel_launch(void* const* d_in, const int* in_sizes, int n_in, void* d_out, int out_size, void* d_ws, size_t ws_size, hipStream_t stream) {
    static int grid = 0;
    if (grid == 0) {
        if (n_in != 26 || out_size != T * DM || ws_size < WS_END) { fprintf(stderr, "kernel_launch: unexpected shapes (n_in %d out %d ws %zu)\n", n_in, out_size, ws_size); grid = -1; return; }
        int dev = 0, cus = 0, per_cu = 0;
        (void)hipGetDevice(&dev);
        (void)hipDeviceGetAttribute(&cus, hipDeviceAttributeMultiprocessorCount, dev);
#if FUSED
        (void)hipFuncSetAttribute((const void*)mega_kernel, hipFuncAttributeMaxDynamicSharedMemorySize, LDS_BYTES);
        (void)hipOccupancyMaxActiveBlocksPerMultiprocessor(&per_cu, (const void*)mega_kernel, NTH, LDS_BYTES);
#else
        per_cu = 1;
#endif
        if (per_cu < 1 || cus < 1) { fprintf(stderr, "kernel_launch: occupancy query gave %d blocks/CU on %d CUs\n", per_cu, cus); grid = -1; return; }
        grid = cus * per_cu;
    }
    if (grid < 0) return;
    Params P{};
    P.x = (const float*)d_in[0]; P.p = (const float*)d_in[1]; P.pos = (const int*)d_in[2];
    P.w_in = (const float*)d_in[3]; P.gla_w_a2 = (const float*)d_in[4]; P.gla_b_a = (const float*)d_in[5]; P.gla_norm_w = (const float*)d_in[6];
    P.swa_sinks = (const float*)d_in[7]; P.lru_conv_w = (const float*)d_in[8]; P.lru_conv_b = (const float*)d_in[9]; P.lru_w_r = (const float*)d_in[10];
    P.lru_b_r = (const float*)d_in[11]; P.lru_w_i = (const float*)d_in[12]; P.lru_b_i = (const float*)d_in[13]; P.lru_lambda = (const float*)d_in[14];
    P.w_out = (const float*)d_in[15]; P.ln1_g = (const float*)d_in[16]; P.ln1_b = (const float*)d_in[17]; P.peer_w_q = (const float*)d_in[18];
    P.peer_sub_keys = (const float*)d_in[19]; P.peer_u = (const float*)d_in[20]; P.peer_v = (const float*)d_in[21]; P.ple_w_gate = (const float*)d_in[22];
    P.ple_w_proj = (const float*)d_in[23]; P.ln2_g = (const float*)d_in[24]; P.ln2_b = (const float*)d_in[25];
    P.out = (float*)d_out; P.ws = (unsigned char*)d_ws;
#if FUSED
    void* args[] = {&P};
    hipError_t e = hipLaunchCooperativeKernel((const void*)mega_kernel, dim3(grid), dim3(NTH), args, LDS_BYTES, stream);
    if (e != hipSuccess) fprintf(stderr, "cooperative launch failed: %s (grid %d)\n", hipGetErrorString(e), grid);
#else
    launch_phase<0>(P, 0, grid, stream);
    for (int layer = 0; layer < 2; ++layer) {
        launch_phase<1>(P, layer, grid, stream); launch_phase<2>(P, layer, grid, stream); launch_phase<3>(P, layer, grid, stream);
        launch_phase<4>(P, layer, grid, stream); launch_phase<5>(P, layer, grid, stream); launch_phase<6>(P, layer, grid, stream);
        launch_phase<7>(P, layer, grid, stream); launch_phase<8>(P, layer, grid, stream);
    }
#endif
}
```
